# Optimizing an MI355X kernel written in HIP

```python
import math
import jax
import jax.numpy as jnp
from jax import lax
import numpy as np

D_MODEL = 1024
BATCH = 32
SEQ = 256
DEPTH = 4
DEC_BATCH = 2
DEC_SEQ = 1024
PAST_LEN = 256

GRID_W = 64
N_MIXERS = 4
N_RET = (DEPTH + 3) // 4
N_RWKV = (DEPTH + 2) // 4
N_DIFF = (DEPTH + 1) // 4
N_NA = DEPTH // 4

RET_HEADS = 4
RET_DK = D_MODEL // RET_HEADS
RET_DV = 2 * RET_DK
RET_QK = RET_HEADS * RET_DK
RET_V = RET_HEADS * RET_DV
RET_CHUNK = 64

RWKV_HD = 64
RWKV_HEADS = D_MODEL // RWKV_HD
RWKV_DECAY_RANK = 64
RWKV_A_RANK = 64

DIFF_HEADS = 8
DIFF_HD = D_MODEL // (2 * DIFF_HEADS)
DIFF_W = DIFF_HEADS * 2 * DIFF_HD

NA_HEADS = 16
NA_HD = D_MODEL // NA_HEADS
NA_WIN_R = 8
NA_WIN_C = 16

ROPE_BASE = 10000.0
Q_BLOCK = 128
EPS = 1e-6
GN_EPS = 1e-5

kernel_name = 'hybrid_ret_rwkv_diff_na_diffusion_step'


def rms_norm(x, w, eps=EPS):
    xf = x.astype(jnp.float32)
    y = xf * lax.rsqrt(jnp.mean(xf * xf, axis=-1, keepdims=True) + eps)
    return (y * w.astype(jnp.float32)).astype(x.dtype)


def head_layer_norm(x, w, eps=GN_EPS):
    xf = x.astype(jnp.float32)
    xc = xf - jnp.mean(xf, axis=-1, keepdims=True)
    return xc * lax.rsqrt(jnp.mean(xc * xc, axis=-1, keepdims=True) + eps) * w.astype(jnp.float32)


def split_heads(t, n_heads):
    b, l, _ = t.shape
    return t.reshape(b, l, n_heads, -1).transpose(0, 2, 1, 3)


def merge_heads(t):
    b, h, l, d = t.shape
    return t.transpose(0, 2, 1, 3).reshape(b, l, h * d)


def ada_modulation(cond, w, b):
    m = jax.nn.silu(cond) @ w + b
    shift, scale, gate = jnp.split(m[:, None, :], 3, axis=-1)
    return shift, scale, gate


def _rope_1d(x, pos):
    d = x.shape[-1]
    inv = ROPE_BASE ** (-jnp.arange(0, d, 2, dtype=jnp.float32) / d)
    ang = pos[:, None] * inv[None, :]
    cos, sin = jnp.cos(ang), jnp.sin(ang)
    x1, x2 = jnp.split(x, 2, axis=-1)
    return jnp.concatenate([x1 * cos - x2 * sin, x1 * sin + x2 * cos], axis=-1)


def axial_rope(x):
    L = x.shape[-2]
    t = jnp.arange(L)
    row = (t // GRID_W).astype(jnp.float32)
    col = (t % GRID_W).astype(jnp.float32)
    xr, xc = jnp.split(x.astype(jnp.float32), 2, axis=-1)
    return jnp.concatenate([_rope_1d(xr, row), _rope_1d(xc, col)], axis=-1).astype(x.dtype)


def centred_shift(x):
    p = jnp.pad(x, ((0, 0), (1, 1), (0, 0)))
    return 0.5 * (p[:, :-2] + p[:, 2:])


def query_blocks(fn, q):
    b, h, l, d = q.shape
    n = l // Q_BLOCK
    qb = q.reshape(b, h, n, Q_BLOCK, d).transpose(2, 0, 1, 3, 4)
    o = lax.map(fn, qb)
    return o.transpose(1, 2, 0, 3, 4).reshape(b, h, l, o.shape[-1])


def dense_attend(q, k, v):
    scale = q.shape[-1] ** -0.5
    def block(qb):
        s = jnp.einsum('bhqd,bhkd->bhqk', qb, k).astype(jnp.float32) * scale
        p = jax.nn.softmax(s, axis=-1).astype(v.dtype)
        return jnp.einsum('bhqk,bhkd->bhqd', p, v)
    return query_blocks(block, q)


def retention_chunkwise(q, k, v, log_g, s0):
    b, h, l, dk = q.shape
    dv = v.shape[-1]
    n = l // RET_CHUNK
    def chunks(t):
        return t.astype(jnp.float32).reshape(b, h, n, RET_CHUNK, t.shape[-1]).transpose(2, 0, 1, 3, 4)
    pos = jnp.arange(RET_CHUNK, dtype=jnp.float32)
    lg = log_g[:, None]
    gap = pos[:, None] - pos[None, :]
    inner_decay = jnp.where(gap >= 0, jnp.exp(lg[:, :, None] * jnp.maximum(gap, 0.0)), 0.0)
    q_decay = jnp.exp(lg * (pos + 1.0))[:, :, None]
    k_decay = jnp.exp(lg * (RET_CHUNK - 1.0 - pos))[:, :, None]
    chunk_decay = jnp.exp(log_g * RET_CHUNK)[:, None, None]
    def step(s, qkv):
        qc, kc, vc = qkv
        att = jnp.einsum('bhqd,bhkd->bhqk', qc, kc) * inner_decay
        o = jnp.einsum('bhqk,bhkv->bhqv', att, vc) + jnp.einsum('bhqd,bhdv->bhqv', qc * q_decay, s)
        s = s * chunk_decay + jnp.einsum('bhkd,bhkv->bhdv', kc * k_decay, vc)
        return s, o
    s, o = lax.scan(step, s0.astype(jnp.float32), (chunks(q), chunks(k), chunks(v)))
    return o.transpose(1, 2, 0, 3, 4).reshape(b, h, l, dv), s


def retention_mixer(h, s0, w_in, decay_logit, gn_w, w_out, latent):
    q, k, v, g = jnp.split(h @ w_in, [RET_QK, 2 * RET_QK, 2 * RET_QK + RET_V], axis=-1)
    q = split_heads(q, RET_HEADS)
    k = split_heads(k, RET_HEADS)
    v = split_heads(v, RET_HEADS)
    if latent:
        q, k = axial_rope(q), axial_rope(k)
    k = k * (RET_DK ** -0.5)
    log_g = jax.nn.log_sigmoid(decay_logit.astype(jnp.float32))
    o_f, s_f = retention_chunkwise(q, k, v, log_g[0], s0[:, 0])
    flip = lambda t: jnp.flip(t, axis=2)
    o_b, s_b = retention_chunkwise(flip(q), flip(k), flip(v), log_g[1], s0[:, 1])
    o = head_layer_norm(o_f + flip(o_b), gn_w.reshape(RET_HEADS, 1, RET_DV))
    o = merge_heads(o).astype(h.dtype) * jax.nn.silu(g)
    return o @ w_out, jnp.stack([s_f, s_b], axis=1)


def rwkv7_scan(r, w, k, v, kk, a, s0):
    def step(s, inp):
        r_t, w_t, k_t, v_t, kk_t, a_t = inp
        sa = jnp.einsum('bhvk,bhk->bhv', s, -kk_t)
        s = (s * w_t[:, :, None, :] + sa[..., None] * (kk_t * a_t)[:, :, None, :]
             + v_t[..., None] * k_t[:, :, None, :])
        return s, jnp.einsum('bhvk,bhk->bhv', s, r_t)
    seq = tuple(jnp.moveaxis(t, 1, 0) for t in (r, w, k, v, kk, a))
    s, y = lax.scan(step, s0.astype(jnp.float32), seq)
    return jnp.moveaxis(y, 0, 1), s


def rwkv7_mixer(h, s0, mu, w_in, w0, wA, wB, a0, aA, aB, k_k, k_a, r_k, gn_w, w_out):
    b, l, d_model = h.shape
    H, hd = RWKV_HEADS, RWKV_HD
    xx = centred_shift(h) - h
    x_r, x_w, x_k, x_v, x_a, x_g = [h + xx * mu[n] for n in range(6)]
    r, k, v, g = jnp.einsum('nbld,dne->nble', jnp.stack([x_r, x_k, x_v, x_g]), w_in.reshape(d_model, 4, d_model))
    to_heads = lambda t: t.astype(jnp.float32).reshape(b, l, H, hd)
    r, k, v = to_heads(r), to_heads(k), to_heads(v)
    kk = k * k_k.astype(jnp.float32).reshape(H, hd)
    kk = kk * lax.rsqrt(jnp.maximum(jnp.sum(kk * kk, axis=-1, keepdims=True), 1e-12))
    ys, bonuses, states = [], [], []
    for dr in range(2):
        wlog = -jax.nn.softplus(-(w0[dr] + jnp.tanh(x_w @ wA[dr]) @ wB[dr])) - 0.5
        decay = to_heads(jnp.exp(-jnp.exp(wlog.astype(jnp.float32))))
        a = to_heads(jax.nn.sigmoid(a0[dr] + (x_a @ aA[dr]) @ aB[dr]))
        kd = k * (1.0 + (a - 1.0) * k_a.astype(jnp.float32).reshape(H, hd))
        seq = (r, decay, kd, v, kk, a)
        if dr == 1:
            seq = tuple(jnp.flip(t, axis=1) for t in seq)
        y_d, s_d = rwkv7_scan(*seq, s0[:, dr])
        if dr == 1:
            y_d = jnp.flip(y_d, axis=1)
        ys.append(y_d)
        bonuses.append(jnp.sum(r * kd * r_k.astype(jnp.float32), axis=-1, keepdims=True) * v)
        states.append(s_d)
    o = head_layer_norm(ys[0] + ys[1], gn_w.reshape(H, hd)) + bonuses[0] + bonuses[1]
    o = o.reshape(b, l, d_model).astype(h.dtype) * jax.nn.silu(g)
    return o @ w_out, jnp.stack(states, axis=1)


def diff_project(h, w_in):
    q, k, v, g = jnp.split(h @ w_in, 4, axis=-1)
    return split_heads(q, DIFF_HEADS), split_heads(k, DIFF_HEADS), split_heads(v, DIFF_HEADS), g


def diff_lambda_value(lam_p, lam_init):
    lp = lam_p.astype(jnp.float32)
    return jnp.exp(jnp.sum(lp[0] * lp[1])) - jnp.exp(jnp.sum(lp[2] * lp[3])) + lam_init


def rope_pair(t):
    t1, t2 = jnp.split(t, 2, axis=-1)
    return jnp.concatenate([axial_rope(t1), axial_rope(t2)], axis=-1)


def diff_attend(q, k, v, lam):
    scale = DIFF_HD ** -0.5
    k1, k2 = jnp.split(k, 2, axis=-1)
    def block(qb):
        q1, q2 = jnp.split(qb, 2, axis=-1)
        p1 = jax.nn.softmax(jnp.einsum('bhqd,bhkd->bhqk', q1, k1).astype(jnp.float32) * scale, axis=-1)
        p2 = jax.nn.softmax(jnp.einsum('bhqd,bhkd->bhqk', q2, k2).astype(jnp.float32) * scale, axis=-1)
        return jnp.einsum('bhqk,bhkv->bhqv', (p1 - lam * p2).astype(v.dtype), v)
    return query_blocks(block, q)


def diff_finish(o, g, gn_w, lam_init, w_out):
    o = rms_norm(o, gn_w.reshape(DIFF_HEADS, 1, 2 * DIFF_HD)) * (1.0 - lam_init)
    return (merge_heads(o) * jax.nn.silu(g)) @ w_out


def na_project(h, w_in):
    q, k, v, g = jnp.split(h @ w_in, 4, axis=-1)
    return split_heads(q, NA_HEADS), split_heads(k, NA_HEADS), split_heads(v, NA_HEADS), g


def na_finish(o, g, w_out):
    return (merge_heads(o) * jax.nn.silu(g)) @ w_out


def neighbourhood_attend(q, k, v, k_ctx, v_ctx, bias_table):
    b, h, l, d = q.shape
    rows = l // GRID_W
    wr = min(NA_WIN_R, rows)
    wc = NA_WIN_C
    scale = d ** -0.5
    r = jnp.arange(rows)
    row_idx = jnp.clip(r - wr // 2, 0, rows - wr)[:, None] + jnp.arange(wr)[None, :]
    c = jnp.arange(GRID_W)
    cs = jnp.clip(c - wc // 2, 0, GRID_W - wc)
    col_ok = (c[None, :] >= cs[:, None]) & (c[None, :] < cs[:, None] + wc)
    row_off = row_idx - r[:, None] + (NA_WIN_R - 1)
    col_off = jnp.clip(c[None, :] - c[:, None], -(wc - 1), wc - 1) + (NA_WIN_C - 1)
    bias = bias_table.astype(jnp.float32)[:, row_off[:, None, :, None], col_off[None, :, None, :]]
    qg = q.reshape(b, h, rows, GRID_W, d)
    kg = k.reshape(b, h, rows, GRID_W, d)[:, :, row_idx]
    vg = v.reshape(b, h, rows, GRID_W, d)[:, :, row_idx]
    s_loc = jnp.einsum('bhrqd,bhrwkd->bhrqwk', qg, kg).astype(jnp.float32) * scale + bias
    s_loc = jnp.where(col_ok[:, None, :], s_loc, -jnp.inf)
    k_ctx = k_ctx.astype(q.dtype)
    v_ctx = v_ctx.astype(v.dtype)
    s_ctx = jnp.einsum('bhrqd,bhcd->bhrqc', qg, k_ctx).astype(jnp.float32) * scale
    n_loc = wr * GRID_W
    p = jax.nn.softmax(jnp.concatenate([s_loc.reshape(b, h, rows, GRID_W, n_loc), s_ctx], axis=-1), axis=-1).astype(v.dtype)
    p_loc = p[..., :n_loc].reshape(b, h, rows, GRID_W, wr, GRID_W)
    p_ctx = p[..., n_loc:]
    o = jnp.einsum('bhrqwk,bhrwkd->bhrqd', p_loc, vg) + jnp.einsum('bhrqc,bhcd->bhrqd', p_ctx, v_ctx)
    return o.reshape(b, h, l, d)


def setup_inputs(seed: int = 0) -> dict:
    key = jax.random.key(seed)
    keys = iter(jax.random.split(key, 48))
    def nrm(shape, scale=1.0):
        return jax.random.normal(next(keys), shape, jnp.float32) * scale
    def gain(shape):
        return 1.0 + nrm(shape, 0.02)
    D = D_MODEL
    ret_gamma_logit = jnp.log(2.0 ** (5.0 + jnp.arange(RET_HEADS, dtype=jnp.float32)) - 1.0)
    rwkv_w0_base = jnp.linspace(-6.0, 1.0, D, dtype=jnp.float32)
    return {
        'x_prompt': nrm((BATCH, SEQ, D)),
        'x_sample': nrm((DEC_BATCH, DEC_SEQ, D)),
        'state_ret': nrm((DEC_BATCH, N_RET, 2, RET_HEADS, RET_DK, RET_DV), 0.1),
        'state_rwkv': nrm((DEC_BATCH, N_RWKV, 2, RWKV_HEADS, RWKV_HD, RWKV_HD), 0.1),
        'cache_diff_k': nrm((DEC_BATCH, N_DIFF, DIFF_HEADS, PAST_LEN, 2 * DIFF_HD)),
        'cache_diff_v': nrm((DEC_BATCH, N_DIFF, DIFF_HEADS, PAST_LEN, 2 * DIFF_HD)),
        'cache_na_k': nrm((DEC_BATCH, N_NA, NA_HEADS, PAST_LEN, NA_HD)),
        'cache_na_v': nrm((DEC_BATCH, N_NA, NA_HEADS, PAST_LEN, NA_HD)),
        'c': nrm((DEC_BATCH, D)),
        'c_ctx': nrm((D,)),
        'norm_w': gain((DEPTH, D)),
        'w_mod': nrm((DEPTH, D, 3 * D), 0.5 * D ** -0.5),
        'b_mod': nrm((DEPTH, 3 * D), 0.1),
        'final_norm_w': gain((D,)),
        'ret_w_in': nrm((N_RET, D, 2 * RET_QK + 2 * RET_V), D ** -0.5),
        'ret_decay': ret_gamma_logit + nrm((N_RET, 2, RET_HEADS), 0.1),
        'ret_gn': gain((N_RET, RET_V)),
        'ret_w_out': nrm((N_RET, RET_V, D), RET_V ** -0.5),
        'rwkv_mu': jax.random.uniform(next(keys), (N_RWKV, 6, D), jnp.float32),
        'rwkv_w_in': nrm((N_RWKV, D, 4 * D), D ** -0.5),
        'rwkv_w0': rwkv_w0_base + nrm((N_RWKV, 2, D), 0.1),
        'rwkv_wA': nrm((N_RWKV, 2, D, RWKV_DECAY_RANK), D ** -0.5),
        'rwkv_wB': nrm((N_RWKV, 2, RWKV_DECAY_RANK, D), 0.5 * RWKV_DECAY_RANK ** -0.5),
        'rwkv_a0': nrm((N_RWKV, 2, D), 0.1),
        'rwkv_aA': nrm((N_RWKV, 2, D, RWKV_A_RANK), D ** -0.5),
        'rwkv_aB': nrm((N_RWKV, 2, RWKV_A_RANK, D), 0.5 * RWKV_A_RANK ** -0.5),
        'rwkv_kk': 0.85 + nrm((N_RWKV, D), 0.02),
        'rwkv_ka': gain((N_RWKV, D)),
        'rwkv_rk': nrm((N_RWKV, RWKV_HEADS, RWKV_HD), 0.1),
        'rwkv_gn': gain((N_RWKV, D)),
        'rwkv_w_out': nrm((N_RWKV, D, D), D ** -0.5),
        'diff_w_in': nrm((N_DIFF, D, 4 * DIFF_W), D ** -0.5),
        'diff_lambda': nrm((N_DIFF, 4, DIFF_HD), 0.1),
        'diff_gn': gain((N_DIFF, DIFF_W)),
        'diff_w_out': nrm((N_DIFF, DIFF_W, D), DIFF_W ** -0.5),
        'na_w_in': nrm((N_NA, D, 4 * D), D ** -0.5),
        'na_bias': nrm((N_NA, NA_HEADS, 2 * NA_WIN_R - 1, 2 * NA_WIN_C - 1), 0.1),
        'na_w_out': nrm((N_NA, D, D), D ** -0.5),
    }


def reference(x_prompt, x_sample, state_ret, state_rwkv, cache_diff_k, cache_diff_v, cache_na_k, cache_na_v,
              c, c_ctx, norm_w, w_mod, b_mod, final_norm_w,
              ret_w_in, ret_decay, ret_gn, ret_w_out,
              rwkv_mu, rwkv_w_in, rwkv_w0, rwkv_wA, rwkv_wB, rwkv_a0, rwkv_aA, rwkv_aB,
              rwkv_kk, rwkv_ka, rwkv_rk, rwkv_gn, rwkv_w_out,
              diff_w_in, diff_lambda, diff_gn, diff_w_out,
              na_w_in, na_bias, na_w_out):
    xp, xs = x_prompt, x_sample
    bp = xp.shape[0]
    new_ret, new_rwkv, new_dk, new_dv, new_nk, new_nv = [], [], [], [], [], []
    for i in range(DEPTH):
        kind, j = i % N_MIXERS, i // N_MIXERS
        sh_p, sc_p, g_p = ada_modulation(c_ctx[None, :], w_mod[i], b_mod[i])
        sh_s, sc_s, g_s = ada_modulation(c, w_mod[i], b_mod[i])
        hp = rms_norm(xp, norm_w[i]) * (1.0 + sc_p) + sh_p
        hs = rms_norm(xs, norm_w[i]) * (1.0 + sc_s) + sh_s
        if kind == 0:
            s0 = jnp.zeros((bp, 2, RET_HEADS, RET_DK, RET_DV), jnp.float32)
            yp, st = retention_mixer(hp, s0, ret_w_in[j], ret_decay[j], ret_gn[j], ret_w_out[j], False)
            ys, _ = retention_mixer(hs, state_ret[:, j], ret_w_in[j], ret_decay[j], ret_gn[j], ret_w_out[j], True)
            new_ret.append(st)
        elif kind == 1:
            rw = (rwkv_mu[j], rwkv_w_in[j], rwkv_w0[j], rwkv_wA[j], rwkv_wB[j], rwkv_a0[j], rwkv_aA[j],
                  rwkv_aB[j], rwkv_kk[j], rwkv_ka[j], rwkv_rk[j], rwkv_gn[j], rwkv_w_out[j])
            s0 = jnp.zeros((bp, 2, RWKV_HEADS, RWKV_HD, RWKV_HD), jnp.float32)
            yp, st = rwkv7_mixer(hp, s0, *rw)
            ys, _ = rwkv7_mixer(hs, state_rwkv[:, j], *rw)
            new_rwkv.append(st)
        elif kind == 2:
            lam_init = 0.8 - 0.6 * math.exp(-0.3 * i)
            lam = diff_lambda_value(diff_lambda[j], lam_init)
            qp, kp, vp, gp = diff_project(hp, diff_w_in[j])
            yp = diff_finish(diff_attend(qp, kp, vp, lam), gp, diff_gn[j], lam_init, diff_w_out[j])
            qs, ks_, vs, gs = diff_project(hs, diff_w_in[j])
            k_all = jnp.concatenate([rope_pair(ks_), cache_diff_k[:, j].astype(ks_.dtype)], axis=2)
            v_all = jnp.concatenate([vs, cache_diff_v[:, j].astype(vs.dtype)], axis=2)
            ys = diff_finish(diff_attend(rope_pair(qs), k_all, v_all, lam), gs, diff_gn[j], lam_init, diff_w_out[j])
            new_dk.append(kp)
            new_dv.append(vp)
        else:
            qp, kp, vp, gp = na_project(hp, na_w_in[j])
            yp = na_finish(dense_attend(qp, kp, vp), gp, na_w_out[j])
            qs, ks_, vs, gs = na_project(hs, na_w_in[j])
            o_s = neighbourhood_attend(qs, ks_, vs, cache_na_k[:, j], cache_na_v[:, j], na_bias[j])
            ys = na_finish(o_s, gs, na_w_out[j])
            new_nk.append(kp)
            new_nv.append(vp)
        xp = xp + g_p * yp
        xs = xs + g_s * ys
    y_prompt = rms_norm(xp, final_norm_w)
    y_sample = rms_norm(xs, final_norm_w)
    return (y_prompt, y_sample, jnp.stack(new_ret, axis=1), jnp.stack(new_rwkv, axis=1),
            jnp.stack(new_dk, axis=1), jnp.stack(new_dv, axis=1),
            jnp.stack(new_nk, axis=1), jnp.stack(new_nv, axis=1))
```

```cpp
#include <hip/hip_runtime.h>
#include <hip/hip_cooperative_groups.h>
#include <cstdio>
namespace cg = cooperative_groups;

typedef unsigned short bf16_t;
using bf16x8 = __attribute__((ext_vector_type(8))) _Float16;
using f32x4 = __attribute__((ext_vector_type(4))) float;
typedef float v2f __attribute__((ext_vector_type(2)));

#define TP_ 8192
#define T_ 10240
#define MIB (1l << 20)

#define OFF_MOD 0l
#define OFF_TAB (256l * 1024)
#define OFF_WT_RET_IN (1 * MIB)
#define OFF_WT_RET_OUT (13 * MIB)
#define OFF_WT_RWKV_IN (17 * MIB)
#define OFF_WT_RWKV_OUT (25 * MIB)
#define OFF_WT_DIFF_IN (27 * MIB)
#define OFF_WT_DIFF_OUT (35 * MIB)
#define OFF_WT_NA_IN (37 * MIB)
#define OFF_WT_NA_OUT (45 * MIB)
#define OFF_WT_LDOWN (47 * MIB)
#define OFF_WT_LUP (47 * MIB + 512 * 1024)
#define ARENA (48 * MIB)
#define OFF_H (ARENA + 0 * MIB)
#define OFF_SH (ARENA + 20 * MIB)
#define OFF_OB (ARENA + 40 * MIB)
#define L0_Q (ARENA + 80 * MIB)
#define L0_K (ARENA + 100 * MIB)
#define L0_G (ARENA + 120 * MIB)
#define L0_VTP (ARENA + 160 * MIB)
#define L0_VTS (ARENA + 192 * MIB)
#define L0_KT (ARENA + 208 * MIB)
#define L0_SP (ARENA + 240 * MIB)
#define L0_PEXT (ARENA + 256 * MIB)
#define L0_O (ARENA + 280 * MIB)
#define L1_RKVG (ARENA + 80 * MIB)
#define L1_L (ARENA + 160 * MIB)
#define L1_DEC (ARENA + 168 * MIB)
#define L1_AA (ARENA + 248 * MIB)
#define L1_Y (ARENA + 328 * MIB)
#define L1_XM (ARENA + 0 * MIB)
#define L1_XW (ARENA + 328 * MIB)
#define L2_O (ARENA + 0 * MIB)
#define L2_Q (ARENA + 60 * MIB)
#define L2_KP (ARENA + 80 * MIB)
#define L2_G (ARENA + 100 * MIB)
#define L2_VTP (ARENA + 120 * MIB)
#define L2_VTS (ARENA + 136 * MIB)
#define L2_KALL (ARENA + 144 * MIB)
#define L2_S1P (ARENA + 152 * MIB)
#define L2_S2P (ARENA + 216 * MIB)
#define L2_S1S (ARENA + 280 * MIB)
#define L2_S2S (ARENA + 360 * MIB)
#define L3_SP (ARENA + 152 * MIB)
#define L3_SS (ARENA + 280 * MIB)

#define OUT_STATE_RET 10485760l
#define OUT_STATE_RWKV 44040192l
#define OUT_DIFF_K 48234496l
#define OUT_DIFF_V 56623104l
#define OUT_NA_K 65011712l
#define OUT_NA_V 73400320l

struct Params {
  const float* in[38];
  float* out;
  char* ws;
};

__device__ __forceinline__ bf16_t f2bf(float f) {
  _Float16 h = (_Float16)f;
  return __builtin_bit_cast(unsigned short, h);
}
__device__ __forceinline__ float bf2f(unsigned h) { return (float)__builtin_bit_cast(_Float16, (unsigned short)h); }
__device__ __forceinline__ unsigned pack2(float a, float b) { return (unsigned)f2bf(a) | ((unsigned)f2bf(b) << 16); }
#define DPPF(x, ctrl) __builtin_bit_cast(float, __builtin_amdgcn_mov_dpp(__builtin_bit_cast(int, (x)), (ctrl), 0xF, 0xF, true))
#define RDLANE(x, l) __builtin_bit_cast(float, __builtin_amdgcn_readlane(__builtin_bit_cast(int, (x)), (l)))
__device__ __forceinline__ float wave_sum(float v) {
  v += DPPF(v, 0xB1);
  v += DPPF(v, 0x4E);
  v += DPPF(v, 0x141);
  v += DPPF(v, 0x140);
  return (RDLANE(v, 0) + RDLANE(v, 16)) + (RDLANE(v, 32) + RDLANE(v, 48));
}
__device__ __forceinline__ float wave_max(float v) {
  v = fmaxf(v, DPPF(v, 0xB1));
  v = fmaxf(v, DPPF(v, 0x4E));
  v = fmaxf(v, DPPF(v, 0x141));
  v = fmaxf(v, DPPF(v, 0x140));
  return fmaxf(fmaxf(RDLANE(v, 0), RDLANE(v, 16)), fmaxf(RDLANE(v, 32), RDLANE(v, 48)));
}
__device__ __forceinline__ float silu_f(float x) { return x * __builtin_amdgcn_rcpf(1.f + __expf(-x)); }
__device__ __forceinline__ int perm_ret(int c) {
  int half = c >> 7, r = c & 127;
  return half * 128 + (r & 1) * 64 + (r >> 1);
}
__device__ __forceinline__ int perm_diff(int c) {
  int rr = c & 31;
  return (c & ~31) + (rr & 1) * 16 + (rr >> 1);
}

enum { EPI_F32 = 0, EPI_RET_IN, EPI_RET_S, EPI_OUT, EPI_BF16, EPI_LUP_W, EPI_LUP_A, EPI_DIFF_IN, EPI_NA_IN, EPI_NA_PV };

struct GemmDesc {
  const bf16_t* A; const bf16_t* B;
  long lda, ldb;
  int M, N, K;
  int nb1, nb2;
  long sA1, sA2, sB1, sB2;
  int epi, bn64, flag, layer;
  float* C; long ldc, sC1, sC2; float scale;
  const float* aux;
};

__device__ __forceinline__ void epilogue(const Params& p, const GemmDesc& g, int b1, int b2, int m, int n, f32x4 v) {
  char* ws = p.ws;
  switch (g.epi) {
    case EPI_F32: {
      int mm = m;
      if (g.flag & 1) mm = perm_ret(m);
      float4 o = make_float4(v[0] * g.scale, v[1] * g.scale, v[2] * g.scale, v[3] * g.scale);
      if (g.flag & 2) *(uint2*)((bf16_t*)g.C + b1 * g.sC1 + b2 * g.sC2 + (long)mm * g.ldc + n) = make_uint2(pack2(o.x, o.y), pack2(o.z, o.w));
      else *(float4*)(g.C + b1 * g.sC1 + b2 * g.sC2 + (long)mm * g.ldc + n) = o;
    } break;
    case EPI_BF16: {
      float a0 = v[0], a1 = v[1], a2 = v[2], a3 = v[3];
      if (g.flag & 1) {
        a0 = 1.f - 2.f * __builtin_amdgcn_rcpf(__expf(2.f * a0) + 1.f); a1 = 1.f - 2.f * __builtin_amdgcn_rcpf(__expf(2.f * a1) + 1.f);
        a2 = 1.f - 2.f * __builtin_amdgcn_rcpf(__expf(2.f * a2) + 1.f); a3 = 1.f - 2.f * __builtin_amdgcn_rcpf(__expf(2.f * a3) + 1.f);
      }
      uint2 o = make_uint2(pack2(a0, a1), pack2(a2, a3));
      *(uint2*)((bf16_t*)g.C + (long)m * g.ldc + n) = o;
    } break;
    case EPI_OUT: {
      int cond = (m < TP_) ? 0 : 1 + ((m - TP_) >> 10);
      const float* gate = (const float*)(ws + OFF_MOD) + ((long)g.layer * 3 + cond) * 3072 + 2048 + n;
      const float* res;
      if (g.layer == 0) res = (m < TP_) ? p.in[0] + (long)m * 1024 + n : p.in[1] + (long)(m - TP_) * 1024 + n;
      else res = p.out + (long)m * 1024 + n;
      float4 r = *(const float4*)res;
      float4 gt = *(const float4*)gate;
      float4 o = make_float4(r.x + gt.x * v[0], r.y + gt.y * v[1], r.z + gt.z * v[2], r.w + gt.w * v[3]);
      *(float4*)(p.out + (long)m * 1024 + n) = o;
    } break;
    case EPI_LUP_W: {
      const float4 w4 = *(const float4*)(g.aux + n);
      const float w0[4] = {w4.x, w4.y, w4.z, w4.w};
      float o[4];
#pragma unroll
      for (int j = 0; j < 4; ++j) o[j] = 0.6065306597126334f * __builtin_amdgcn_rcpf(1.f + __expf(-(w0[j] + v[j])));
      *(uint2*)((bf16_t*)g.C + (long)m * 1024 + n) = make_uint2(pack2(o[0], o[1]), pack2(o[2], o[3]));
    } break;
    case EPI_LUP_A: {
      const float4 a4 = *(const float4*)(g.aux + n);
      const float a0[4] = {a4.x, a4.y, a4.z, a4.w};
      float o[4];
#pragma unroll
      for (int j = 0; j < 4; ++j) o[j] = __builtin_amdgcn_rcpf(1.f + __expf(-(a0[j] + v[j])));
      *(uint2*)((bf16_t*)g.C + (long)m * 1024 + n) = make_uint2(pack2(o[0], o[1]), pack2(o[2], o[3]));
    } break;
    case EPI_RET_IN: {
      const bool sample = m >= TP_;
      const int sb = (m - TP_) >> 10, ls = (m - TP_) & 1023;
      const int pb = m >> 8, lp = m & 255;
      const float* lg = (const float*)(ws + OFF_TAB);
      if (n < 2048) {
        const bool isk = n >= 1024;
        const int c = n & 1023, h = c >> 8, dk = c & 255;
        float x[4] = {v[0], v[1], v[2], v[3]};
        if (isk) { x[0] *= 0.0625f; x[1] *= 0.0625f; x[2] *= 0.0625f; x[3] *= 0.0625f; }
        if (sample) {
          const int half = dk >> 7;
          const float pos = half ? (float)(ls & 63) : (float)(ls >> 6);
#pragma unroll
          for (int pp = 0; pp < 2; ++pp) {
            int i = ((dk & 127) >> 1) + pp;
            float inv = __builtin_amdgcn_exp2f(-(float)i * (13.287712379549449f / 64.f));
            float ang = pos * inv;
            float cs = __cosf(ang), sn = __sinf(ang);
            float x1 = x[2 * pp], x2 = x[2 * pp + 1];
            x[2 * pp] = x1 * cs - x2 * sn;
            x[2 * pp + 1] = x1 * sn + x2 * cs;
          }
        }
        bf16_t* dst = (bf16_t*)(ws + (isk ? L0_K : L0_Q)) + (long)m * 1024 + c;
        *(uint2*)dst = make_uint2(pack2(x[0], x[1]), pack2(x[2], x[3]));
        if (sample && !isk) {
          float df = __expf(lg[h] * (float)(ls + 1));
          float db = __expf(lg[4 + h] * (float)(1024 - ls));
          bf16_t* pe = (bf16_t*)(ws + L0_PEXT) + ((long)(sb * 4 + h) * 1024 + ls) * 1536 + 1024 + dk;
          *(uint2*)pe = make_uint2(pack2(x[0] * df, x[1] * df), pack2(x[2] * df, x[3] * df));
          *(uint2*)(pe + 256) = make_uint2(pack2(x[0] * db, x[1] * db), pack2(x[2] * db, x[3] * db));
        }
        if (!sample && isk) {
          float df = __expf(lg[h] * (float)(255 - lp));
          float db = __expf(lg[4 + h] * (float)lp);
          bf16_t* kt0 = (bf16_t*)(ws + L0_KT) + ((long)((0 * 32 + pb) * 4 + h) * 256 + dk) * 256 + lp;
          bf16_t* kt1 = (bf16_t*)(ws + L0_KT) + ((long)((1 * 32 + pb) * 4 + h) * 256 + dk) * 256 + lp;
#pragma unroll
          for (int j = 0; j < 4; ++j) { kt0[j * 256] = f2bf(x[j] * df); kt1[j * 256] = f2bf(x[j] * db); }
        }
      } else if (n < 4096) {
        const int c = n - 2048, h = c >> 9, dv = c & 511;
        if (sample) {
          bf16_t* vt = (bf16_t*)(ws + L0_VTS) + ((long)(sb * 4 + h) * 512 + dv) * 1536 + ls;
#pragma unroll
          for (int j = 0; j < 4; ++j) vt[j * 1536] = f2bf(v[j]);
        } else {
          bf16_t* vt = (bf16_t*)(ws + L0_VTP) + ((long)(pb * 4 + h) * 512 + dv) * 256 + lp;
#pragma unroll
          for (int j = 0; j < 4; ++j) vt[j * 256] = f2bf(v[j]);
        }
      } else {
        bf16_t* dst = (bf16_t*)(ws + L0_G) + (long)m * 2048 + (n - 4096);
        *(uint2*)dst = make_uint2(pack2(v[0], v[1]), pack2(v[2], v[3]));
      }
    } break;
    case EPI_RET_S: {
      const float* lg = (const float*)(ws + OFF_TAB);
      const float lgf = lg[b2], lgb = lg[4 + b2];
      float o[4];
#pragma unroll
      for (int j = 0; j < 4; ++j) {
        int d = m - (n + j);
        float arg = (d > 0) ? lgf * (float)d : lgb * (float)(-d);
        float f = (d == 0) ? 2.f : __expf(arg);
        o[j] = v[j] * f;
      }
      bf16_t* dst = (bf16_t*)g.C + b1 * g.sC1 + b2 * g.sC2 + (long)m * g.ldc + n;
      *(uint2*)dst = make_uint2(pack2(o[0], o[1]), pack2(o[2], o[3]));
    } break;
    case EPI_DIFF_IN: {
      const bool sample = m >= TP_;
      const int sb = (m - TP_) >> 10, ls = (m - TP_) & 1023;
      const int pb = m >> 8, lp = m & 255;
      if (n < 2048) {
        const bool isk = n >= 1024;
        const int c = n & 1023, h = c >> 7, d = c & 127;
        float x[4] = {v[0], v[1], v[2], v[3]};
        if (sample) {
          const int half = (d >> 5) & 1;
          const float pos = half ? (float)(ls & 63) : (float)(ls >> 6);
#pragma unroll
          for (int pp = 0; pp < 2; ++pp) {
            int i = ((d & 31) >> 1) + pp;
            float inv = __builtin_amdgcn_exp2f(-(float)i * (13.287712379549449f / 16.f));
            float ang = pos * inv;
            float cs = __cosf(ang), sn = __sinf(ang);
            float x1 = x[2 * pp], x2 = x[2 * pp + 1];
            x[2 * pp] = x1 * cs - x2 * sn;
            x[2 * pp + 1] = x1 * sn + x2 * cs;
          }
        }
        uint2 pk = make_uint2(pack2(x[0], x[1]), pack2(x[2], x[3]));
        if (!isk) {
          *(uint2*)((bf16_t*)(ws + L2_Q) + (long)m * 1024 + c) = pk;
        } else if (sample) {
          *(uint2*)((bf16_t*)(ws + L2_KALL) + ((long)(sb * 8 + h) * 1280 + ls) * 128 + d) = pk;
        } else {
          *(uint2*)((bf16_t*)(ws + L2_KP) + (long)m * 1024 + c) = pk;
          float* ck = p.out + OUT_DIFF_K + ((long)(pb * 8 + h) * 256 + lp) * 128 + (d & ~31) + ((d & 31) >> 1);
          *(float2*)ck = make_float2(v[0], v[2]);
          *(float2*)(ck + 16) = make_float2(v[1], v[3]);
        }
      } else if (n < 3072) {
        const int c = n - 2048, h = c >> 7, dv = c & 127;
        if (sample) {
          bf16_t* vt = (bf16_t*)(ws + L2_VTS) + ((long)(sb * 8 + h) * 128 + dv) * 1280 + ls;
#pragma unroll
          for (int j = 0; j < 4; ++j) vt[j * 1280] = f2bf(v[j]);
        } else {
          bf16_t* vt = (bf16_t*)(ws + L2_VTP) + ((long)(pb * 8 + h) * 128 + dv) * 256 + lp;
#pragma unroll
          for (int j = 0; j < 4; ++j) vt[j * 256] = f2bf(v[j]);
          *(float4*)(p.out + OUT_DIFF_V + ((long)(pb * 8 + h) * 256 + lp) * 128 + dv) = make_float4(v[0], v[1], v[2], v[3]);
        }
      } else {
        *(uint2*)((bf16_t*)(ws + L2_G) + (long)m * 1024 + (n - 3072)) = make_uint2(pack2(v[0], v[1]), pack2(v[2], v[3]));
      }
    } break;
    case EPI_NA_IN: {
      const bool sample = m >= TP_;
      const int sb = (m - TP_) >> 10, ls = (m - TP_) & 1023;
      const int pb = m >> 8, lp = m & 255;
      uint2 pk = make_uint2(pack2(v[0], v[1]), pack2(v[2], v[3]));
      if (n < 1024) {
        *(uint2*)((bf16_t*)(ws + L2_Q) + (long)m * 1024 + n) = pk;
      } else if (n < 2048) {
        const int c = n - 1024, h = c >> 6, d = c & 63;
        if (sample) {
          *(uint2*)((bf16_t*)(ws + L2_KALL) + ((long)(sb * 16 + h) * 1280 + ls) * 64 + d) = pk;
        } else {
          *(uint2*)((bf16_t*)(ws + L2_KP) + (long)m * 1024 + c) = pk;
          *(float4*)(p.out + OUT_NA_K + ((long)(pb * 16 + h) * 256 + lp) * 64 + d) = make_float4(v[0], v[1], v[2], v[3]);
        }
      } else if (n < 3072) {
        const int c = n - 2048, h = c >> 6, dv = c & 63;
        if (sample) {
          bf16_t* vt = (bf16_t*)(ws + L2_VTS) + ((long)(sb * 16 + h) * 64 + dv) * 1280 + ls;
#pragma unroll
          for (int j = 0; j < 4; ++j) vt[j * 1280] = f2bf(v[j]);
        } else {
          bf16_t* vt = (bf16_t*)(ws + L2_VTP) + ((long)(pb * 16 + h) * 64 + dv) * 256 + lp;
#pragma unroll
          for (int j = 0; j < 4; ++j) vt[j * 256] = f2bf(v[j]);
          *(float4*)(p.out + OUT_NA_V + ((long)(pb * 16 + h) * 256 + lp) * 64 + dv) = make_float4(v[0], v[1], v[2], v[3]);
        }
      } else {
        *(uint2*)((bf16_t*)(ws + L2_G) + (long)m * 1024 + (n - 3072)) = pk;
      }
    } break;
  }
}

#define LDS_STRIDE 64
typedef __attribute__((address_space(3))) unsigned lds_u32;
template <int NT, int MI>
__device__ __forceinline__ void gemm_tile(const Params& p, const GemmDesc& g, int b1, int b2, int m0, int n0, char* smem) {
  constexpr int BN = NT * 32;
  constexpr int BM = MI * 32;
  bf16_t* As = (bf16_t*)smem;
  bf16_t* Bs = As + 2 * BM * LDS_STRIDE;
  const int tid = threadIdx.x, lane = tid & 63, wave = tid >> 6, wr = wave >> 1, wc = wave & 1, l15 = lane & 15, q4 = lane >> 4;
  const bf16_t* Ab = g.A + b1 * g.sA1 + b2 * g.sA2 + (long)m0 * g.lda;
  const bf16_t* Bb = g.B + b1 * g.sB1 + b2 * g.sB2 + (long)n0 * g.ldb;
  f32x4 acc[MI][NT];
#pragma unroll
  for (int i = 0; i < MI; ++i)
#pragma unroll
    for (int j = 0; j < NT; ++j) acc[i][j] = (f32x4){0.f, 0.f, 0.f, 0.f};
  const int nk = g.K >> 6;
  const int rsw = (l15 >> 1) & 7;
  const int prow = lane >> 3;
  const int gch = (lane & 7) ^ (((wave & 1) << 2) | (prow >> 1));
  const bf16_t* Ag = Ab + (long)(wave * 8 + prow) * g.lda + gch * 8;
  const bf16_t* Bg = Bb + (long)(wave * 8 + prow) * g.ldb + gch * 8;
  const long a32 = 32 * g.lda, b32 = 32 * g.ldb;
#define DMA(kt, buf)                                                                                         \
  {                                                                                                          \
    _Pragma("unroll") for (int i = 0; i < MI; ++i)                                                           \
      __builtin_amdgcn_global_load_lds((const unsigned*)(Ag + i * a32 + (kt) * 64),                          \
          (lds_u32*)((char*)As + (buf) * (BM * 128) + (i * 4 + wave) * 1024 + lane * 16), 16, 0, 0);         \
    _Pragma("unroll") for (int i = 0; i < NT / 1; ++i) if (i < BN / 32)                                      \
      __builtin_amdgcn_global_load_lds((const unsigned*)(Bg + i * b32 + (kt) * 64),                          \
          (lds_u32*)((char*)Bs + (buf) * (BN * 128) + (i * 4 + wave) * 1024 + lane * 16), 16, 0, 0);         \
  }
  bf16x8 af[2][MI], bfr[2][NT];
#define LOADFRAGS(buf)                                                                     \
  _Pragma("unroll") for (int ks = 0; ks < 2; ++ks) {                                       \
    _Pragma("unroll") for (int mi = 0; mi < MI; ++mi)                                      \
      af[ks][mi] = *(const bf16x8*)(As + ((buf) * BM + wr * (MI * 16) + mi * 16 + l15) * LDS_STRIDE + (((ks * 4 + q4) ^ rsw) << 3)); \
    _Pragma("unroll") for (int ni = 0; ni < NT; ++ni)                                      \
      bfr[ks][ni] = *(const bf16x8*)(Bs + ((buf) * BN + wc * (NT * 16) + ni * 16 + l15) * LDS_STRIDE + (((ks * 4 + q4) ^ rsw) << 3)); \
  }
#define COMPUTE()                                                                          \
  _Pragma("unroll") for (int ks = 0; ks < 2; ++ks)                                         \
    _Pragma("unroll") for (int mi = 0; mi < MI; ++mi)                                      \
      _Pragma("unroll") for (int ni = 0; ni < NT; ++ni)                                    \
        acc[mi][ni] = __builtin_amdgcn_mfma_f32_16x16x32_f16(bfr[ks][ni], af[ks][mi], acc[mi][ni], 0, 0, 0);
  DMA(0, 0)
  asm volatile("s_waitcnt vmcnt(0)" ::: "memory");
  __syncthreads();
  for (int kt = 0; kt < nk; ++kt) {
    const int buf = kt & 1;
    LOADFRAGS(buf)
    __builtin_amdgcn_sched_barrier(0);
    if (kt + 1 < nk) DMA(kt + 1, buf ^ 1)
    __builtin_amdgcn_sched_barrier(0);
    COMPUTE()
    __builtin_amdgcn_sched_barrier(0);
    asm volatile("s_waitcnt vmcnt(0)" ::: "memory");
    __syncthreads();
  }
#undef LOADFRAGS
#undef COMPUTE
#undef DMA
#pragma unroll
  for (int mi = 0; mi < MI; ++mi)
#pragma unroll
    for (int ni = 0; ni < NT; ++ni) {
      int m = m0 + wr * (MI * 16) + mi * 16 + l15;
      int n = n0 + wc * (NT * 16) + ni * 16 + q4 * 4;
      epilogue(p, g, b1, b2, m, n, acc[mi][ni]);
    }
}

__device__ __forceinline__ int desc_tiles(const GemmDesc& g) {
  int bn = g.bn64 ? 64 : 128;
  int bm = (g.flag & 256) ? 160 : 128;
  return g.nb1 * g.nb2 * (g.M / bm) * (g.N / bn);
}
__device__ __forceinline__ void run_desc_tile(const Params& p, const GemmDesc& g, int tile, char* smem) {
  int bn = g.bn64 ? 64 : 128;
  int bm = (g.flag & 256) ? 160 : 128;
  int tm = g.M / bm, tn = g.N / bn;
  int per = tm * tn;
  int batch = tile / per, rem = tile - batch * per;
  int nt = rem / tm, mt = rem - nt * tm;
  if (false && g.nb1 * g.nb2 == 1 && (tm & 7) == 0) {
    int snw = tn < 8 ? tn : 8;
    int sz = 8 * snw;
    int sup = rem / sz, within = rem - sup * sz;
    int nsm = tm >> 3;
    int sn = sup / nsm, sm_ = sup - sn * nsm;
    mt = sm_ * 8 + (within & 7);
    nt = sn * snw + (within >> 3);
  }
  int b1 = batch / g.nb2, b2 = batch - b1 * g.nb2;
  if (g.flag & 256) gemm_tile<4, 5>(p, g, b1, b2, mt * 160, nt * 128, smem);
  else if (g.bn64) gemm_tile<2, 4>(p, g, b1, b2, mt * 128, nt * 64, smem);
  else gemm_tile<4, 4>(p, g, b1, b2, mt * 128, nt * 128, smem);
}

__device__ __forceinline__ GemmDesc mkdesc(const void* A, long lda, const void* B, long ldb, int M, int N, int K, int epi) {
  GemmDesc g;
  g.A = (const bf16_t*)A; g.B = (const bf16_t*)B;
  g.lda = lda; g.ldb = ldb; g.M = M; g.N = N; g.K = K; g.nb1 = 1; g.nb2 = 1;
  g.sA1 = g.sA2 = g.sB1 = g.sB2 = 0; g.epi = epi; g.bn64 = 0; g.flag = 0; g.layer = 0;
  g.C = nullptr; g.ldc = 0; g.sC1 = g.sC2 = 0; g.scale = 1.f; g.aux = nullptr;
  return g;
}

__device__ __forceinline__ int get_descs(const Params& p, int gp, int idx, GemmDesc& g) {
  char* ws = p.ws;
  switch (gp) {
    case 0:
      g = mkdesc(ws + OFF_H, 1024, ws + OFF_WT_RET_IN, 1024, T_, 6144, 1024, EPI_RET_IN); g.flag = 256;
      return 1;
    case 1:
      if (idx == 0) {
        g = mkdesc(ws + L0_Q, 1024, ws + L0_K, 1024, 256, 256, 256, EPI_RET_S);
        g.nb1 = 32; g.nb2 = 4; g.sA1 = 256 * 1024; g.sA2 = 256; g.sB1 = 256 * 1024; g.sB2 = 256;
        g.C = (float*)(ws + L0_SP); g.ldc = 256; g.sC1 = 4 * 65536; g.sC2 = 65536;
      } else if (idx == 1) {
        g = mkdesc((bf16_t*)(ws + L0_Q) + (long)TP_ * 1024, 1024, (bf16_t*)(ws + L0_K) + (long)TP_ * 1024, 1024, 1024, 1024, 256, EPI_RET_S);
        g.nb1 = 2; g.nb2 = 4; g.sA1 = 1024 * 1024; g.sA2 = 256; g.sB1 = 1024 * 1024; g.sB2 = 256;
        g.C = (float*)(ws + L0_PEXT); g.ldc = 1536; g.sC1 = 4l * 1024 * 1536; g.sC2 = 1024l * 1536;
      } else {
        int dir = idx - 2;
        g = mkdesc((bf16_t*)(ws + L0_KT) + (long)dir * 32 * 4 * 65536, 256, ws + L0_VTP, 256, 256, 512, 256, EPI_F32);
        g.nb1 = 32; g.nb2 = 4; g.sA1 = 4 * 65536; g.sA2 = 65536; g.sB1 = 4 * 131072; g.sB2 = 131072;
        g.C = p.out + OUT_STATE_RET + (long)dir * 4 * 131072; g.ldc = 512; g.sC1 = 8 * 131072; g.sC2 = 131072; g.flag = 1;
      }
      return 4;
    case 2:
      if (idx == 1) {
        g = mkdesc(ws + L0_SP, 256, ws + L0_VTP, 256, 256, 512, 256, EPI_F32);
        g.nb1 = 32; g.nb2 = 4; g.sA1 = 4 * 65536; g.sA2 = 65536; g.sB1 = 4 * 131072; g.sB2 = 131072;
        g.C = (float*)(ws + L0_O); g.ldc = 2048; g.sC1 = 256 * 2048; g.sC2 = 512; g.flag = 2;
      } else {
        g = mkdesc(ws + L0_PEXT, 1536, ws + L0_VTS, 1536, 1024, 512, 1536, EPI_F32);
        g.nb1 = 2; g.nb2 = 4; g.sA1 = 4l * 1024 * 1536; g.sA2 = 1024l * 1536; g.sB1 = 4l * 512 * 1536; g.sB2 = 512l * 1536;
        g.C = (float*)((bf16_t*)(ws + L0_O) + (long)TP_ * 2048); g.ldc = 2048; g.sC1 = 1024 * 2048; g.sC2 = 512; g.flag = 2;
      }
      return 2;
    case 3:
      g = mkdesc(ws + OFF_OB, 2048, ws + OFF_WT_RET_OUT, 2048, T_, 1024, 2048, EPI_OUT); g.layer = 0; g.flag = 256;
      return 1;
    case 4: {
      if (idx < 4) {
        g = mkdesc(ws + L1_XM + (long)idx * 20 * MIB, 1024, (bf16_t*)(ws + OFF_WT_RWKV_IN) + (long)idx * 1024 * 1024, 1024, T_, 1024, 1024, EPI_BF16);
        g.C = (float*)((bf16_t*)(ws + L1_RKVG) + idx * 1024); g.ldc = 4096;
      } else {
        int w = idx - 4;
        g = mkdesc(ws + L1_XW + (long)w * 20 * MIB, 1024, (bf16_t*)(ws + OFF_WT_LDOWN) + (long)w * 128 * 1024, 1024, T_, 128, 1024, EPI_BF16);
        g.C = (float*)((bf16_t*)(ws + L1_L) + w * 128); g.ldc = 256; g.flag = (w == 0) ? 1 : 0;
      }
      return 6;
    }
    case 5: {
      int dir = idx >> 1, type = idx & 1;
      g = mkdesc((bf16_t*)(ws + L1_L) + type * 128 + dir * 64, 256, (bf16_t*)(ws + OFF_WT_LUP) + (long)(type * 2 + dir) * 65536, 64, T_, 1024, 64,
                 type ? EPI_LUP_A : EPI_LUP_W);
      g.C = (float*)((bf16_t*)(ws + (type ? L1_AA : L1_DEC)) + (long)dir * T_ * 1024);
      g.aux = (type ? p.in[23] : p.in[20]) + dir * 1024;
      return 4;
    }
    case 6:
      g = mkdesc(ws + OFF_OB, 1024, ws + OFF_WT_RWKV_OUT, 1024, T_, 1024, 1024, EPI_OUT); g.layer = 1; g.flag = 256;
      return 1;
    case 7:
      g = mkdesc(ws + OFF_H, 1024, ws + OFF_WT_DIFF_IN, 1024, T_, 4096, 1024, EPI_DIFF_IN); g.flag = 256;
      return 1;
    case 10:
      g = mkdesc(ws + OFF_OB, 1024, ws + OFF_WT_DIFF_OUT, 1024, T_, 1024, 1024, EPI_OUT); g.layer = 2; g.flag = 256;
      return 1;
    case 11:
      g = mkdesc(ws + OFF_H, 1024, ws + OFF_WT_NA_IN, 1024, T_, 4096, 1024, EPI_NA_IN); g.flag = 256;
      return 1;
    case 14:
      g = mkdesc(ws + OFF_OB, 1024, ws + OFF_WT_NA_OUT, 1024, T_, 1024, 1024, EPI_OUT); g.layer = 3; g.flag = 256;
      return 1;
  }
  return 0;
}

__device__ __forceinline__ void gemm_phase(const Params& p, int gp, char* smem, int vb) {
  GemmDesc g;
  int nd = get_descs(p, gp, 0, g);
  int base = 0;
  int tile = vb;
  for (int d = 0; d < nd; ++d) {
    if (d > 0) get_descs(p, gp, d, g);
    int nt = desc_tiles(g);
    while (tile < base + nt) {
      run_desc_tile(p, g, tile - base, smem);
      tile += gridDim.x;
    }
    base += nt;
  }
}

struct TJob { const float* src; int K, N; bf16_t* dst; int perm; };
__device__ __forceinline__ TJob tjob(const Params& p, int j) {
  char* ws = p.ws;
  TJob t; t.perm = 0;
  switch (j) {
    case 0: t.src = p.in[14]; t.K = 1024; t.N = 6144; t.dst = (bf16_t*)(ws + OFF_WT_RET_IN); t.perm = 1; break;
    case 1: t.src = p.in[17]; t.K = 2048; t.N = 1024; t.dst = (bf16_t*)(ws + OFF_WT_RET_OUT); break;
    case 2: t.src = p.in[19]; t.K = 1024; t.N = 4096; t.dst = (bf16_t*)(ws + OFF_WT_RWKV_IN); break;
    case 3: t.src = p.in[30]; t.K = 1024; t.N = 1024; t.dst = (bf16_t*)(ws + OFF_WT_RWKV_OUT); break;
    case 4: t.src = p.in[31]; t.K = 1024; t.N = 4096; t.dst = (bf16_t*)(ws + OFF_WT_DIFF_IN); t.perm = 2; break;
    case 5: t.src = p.in[34]; t.K = 1024; t.N = 1024; t.dst = (bf16_t*)(ws + OFF_WT_DIFF_OUT); break;
    case 6: t.src = p.in[35]; t.K = 1024; t.N = 4096; t.dst = (bf16_t*)(ws + OFF_WT_NA_IN); break;
    case 7: t.src = p.in[37]; t.K = 1024; t.N = 1024; t.dst = (bf16_t*)(ws + OFF_WT_NA_OUT); break;
    case 8: case 9: t.src = p.in[21] + (j - 8) * 65536; t.K = 1024; t.N = 64; t.dst = (bf16_t*)(ws + OFF_WT_LDOWN) + (long)(j - 8) * 64 * 1024; break;
    case 10: case 11: t.src = p.in[24] + (j - 10) * 65536; t.K = 1024; t.N = 64; t.dst = (bf16_t*)(ws + OFF_WT_LDOWN) + (long)(128 + (j - 10) * 64) * 1024; break;
    case 12: case 13: t.src = p.in[22] + (j - 12) * 65536; t.K = 64; t.N = 1024; t.dst = (bf16_t*)(ws + OFF_WT_LUP) + (long)(j - 12) * 65536; break;
    default: t.src = p.in[25] + (j - 14) * 65536; t.K = 64; t.N = 1024; t.dst = (bf16_t*)(ws + OFF_WT_LUP) + (long)(2 + j - 14) * 65536; break;
  }
  return t;
}

__device__ __forceinline__ void transpose_tile(const TJob& t, int tile, char* smem) {
  float* sm = (float*)smem;
  const int tid = threadIdx.x;
  int tn = t.N >> 6;
  int kt = tile / tn, nt = tile - kt * tn;
  int k0 = kt * 64, n0 = nt * 64;
  __syncthreads();
#pragma unroll
  for (int it = 0; it < 16; ++it) {
    int kk = it * 4 + (tid >> 6), nn = tid & 63;
    int nd = n0 + nn;
    int ns = nd;
    if (t.perm == 1 && nd < 2048) ns = (nd & ~255) + perm_ret(nd & 255);
    else if (t.perm == 2 && nd < 2048) ns = perm_diff(nd);
    sm[kk * 65 + nn] = t.src[(long)(k0 + kk) * t.N + ns];
  }
  __syncthreads();
#pragma unroll
  for (int it = 0; it < 2; ++it) {
    int gidx = tid + it * 256;
    int n = gidx >> 3, kg = gidx & 7;
    unsigned w[4];
#pragma unroll
    for (int e = 0; e < 4; ++e) w[e] = pack2(sm[(kg * 8 + 2 * e) * 65 + n], sm[(kg * 8 + 2 * e + 1) * 65 + n]);
    *(uint4*)(t.dst + (long)(n0 + n) * t.K + k0 + kg * 8) = make_uint4(w[0], w[1], w[2], w[3]);
  }
}

__device__ __forceinline__ void ret_s0_prep(const Params& p) {
  char* ws = p.ws;
  const long gtid = (long)blockIdx.x * 256 + threadIdx.x;
  const long gn = (long)gridDim.x * 256;
  for (long i = gtid; i < 2l * 4 * 512 * 512; i += gn) {
    int col = i & 511; long r = i >> 9; int dv = r & 511; r >>= 9; int h = r & 3; int sb = r >> 2;
    int dir = col >> 8, dkp = col & 255;
    float v = p.in[2][((((long)sb * 2 + dir) * 4 + h) * 256 + perm_ret(dkp)) * 512 + dv];
    ((bf16_t*)(ws + L0_VTS))[((long)(sb * 4 + h) * 512 + dv) * 1536 + 1024 + col] = f2bf(v);
  }
}

__device__ __forceinline__ void transposes_subset(const Params& p, char* smem, unsigned mask, int worker, int nworkers) {
  int base = 0, tile = worker;
  for (int j = 0; j < 16; ++j) {
    if (!((mask >> j) & 1u)) continue;
    TJob t = tjob(p, j);
    int nt = (t.K >> 6) * (t.N >> 6);
    while (tile < base + nt) { transpose_tile(t, tile - base, smem); tile += nworkers; }
    base += nt;
  }
  __syncthreads();
}
__device__ __forceinline__ void mod_gemv_items(const Params& p, char* smem, int item_lo, int item_hi, int worker, int nworkers) {
  char* ws = p.ws;
  const int tid = threadIdx.x;

    float* sm = (float*)smem;
    const float* wmod = p.in[11];
    const float* bmod = p.in[12];
    for (int item = item_lo + worker; item < item_hi; item += nworkers) {
      int layer = item / 192, cg16 = item - layer * 192;
      int j0 = cg16 * 16;
      int c4 = tid & 3, r = tid >> 2;
      float acc[3][4];
#pragma unroll
      for (int c = 0; c < 3; ++c)
#pragma unroll
        for (int e = 0; e < 4; ++e) acc[c][e] = 0.f;
      float4 wr[16];
#pragma unroll
      for (int it = 0; it < 16; ++it)
        wr[it] = *(const float4*)(wmod + ((long)layer * 1024 + r + it * 64) * 3072 + j0 + c4 * 4);
#pragma unroll
      for (int it = 0; it < 16; ++it) {
        int row = r + it * 64;
        float4 w = wr[it];
        float cv0 = p.in[9][row], cv1 = p.in[8][row], cv2 = p.in[8][1024 + row];
        float s0 = silu_f(cv0), s1 = silu_f(cv1), s2 = silu_f(cv2);
        acc[0][0] += s0 * w.x; acc[0][1] += s0 * w.y; acc[0][2] += s0 * w.z; acc[0][3] += s0 * w.w;
        acc[1][0] += s1 * w.x; acc[1][1] += s1 * w.y; acc[1][2] += s1 * w.z; acc[1][3] += s1 * w.w;
        acc[2][0] += s2 * w.x; acc[2][1] += s2 * w.y; acc[2][2] += s2 * w.z; acc[2][3] += s2 * w.w;
      }
      __syncthreads();
#pragma unroll
      for (int c = 0; c < 3; ++c)
#pragma unroll
        for (int e = 0; e < 4; ++e) sm[tid * 12 + c * 4 + e] = acc[c][e];
      __syncthreads();
      if (tid < 48) {
        int c = tid / 16, col = tid & 15;
        int cc4 = col >> 2, e = col & 3;
        float s = 0.f;
        for (int rr = 0; rr < 64; ++rr) s += sm[(rr * 4 + cc4) * 12 + c * 4 + e];
        ((float*)(ws + OFF_MOD))[((long)layer * 3 + c) * 3072 + j0 + col] = s + bmod[layer * 3072 + j0 + col];
      }
    }
    __syncthreads();
}

__device__ __forceinline__ void prep_phase(const Params& p, char* smem) {
  char* ws = p.ws;
  const int tid = threadIdx.x;
  transposes_subset(p, smem, (gridDim.x == 512) ? 0x0001u : 0xFFFFu, blockIdx.x, gridDim.x);
  __syncthreads();
  mod_gemv_items(p, smem, 0, (gridDim.x == 512) ? 192 : 768, blockIdx.x, gridDim.x);
  const long gtid = (long)blockIdx.x * 256 + tid;
  const long gn = (long)gridDim.x * 256;
  if (gtid < 8) {
    float x = p.in[15][gtid];
    float u = -x;
    ((float*)(ws + OFF_TAB))[gtid] = -(fmaxf(u, 0.f) + log1pf(expf(-fabsf(u))));
  }
  if (gridDim.x != 512) ret_s0_prep(p);
}

__device__ __forceinline__ void diff_cache_prep(const Params& p) {
  char* ws = p.ws;
  const long gtid = (long)blockIdx.x * 256 + threadIdx.x;
  const long gn = (long)gridDim.x * 256;
  for (long i = gtid; i < 2l * 8 * 256 * 128; i += gn) {
    int d = i & 127; long r = i >> 7; int pp = r & 255; r >>= 8; int h = r & 7; int sb = r >> 3;
    float kv = p.in[4][((long)(sb * 8 + h) * 256 + pp) * 128 + perm_diff(d)];
    ((bf16_t*)(ws + L2_KALL))[((long)(sb * 8 + h) * 1280 + 1024 + pp) * 128 + d] = f2bf(kv);
  }
  for (long i = gtid; i < 2l * 8 * 128 * 256; i += gn) {
    int pp = i & 255; long r = i >> 8; int dv = r & 127; r >>= 7; int h = r & 7; int sb = r >> 3;
    float vv = p.in[5][((long)(sb * 8 + h) * 256 + pp) * 128 + dv];
    ((bf16_t*)(ws + L2_VTS))[((long)(sb * 8 + h) * 128 + dv) * 1280 + 1024 + pp] = f2bf(vv);
  }
}

__device__ __forceinline__ void na_cache_prep(const Params& p) {
  char* ws = p.ws;
  const long gtid = (long)blockIdx.x * 256 + threadIdx.x;
  const long gn = (long)gridDim.x * 256;
  for (long i = gtid; i < 2l * 16 * 256 * 64; i += gn) {
    int d = i & 63; long r = i >> 6; int pp = r & 255; r >>= 8; int h = r & 15; int sb = r >> 4;
    float kv = p.in[6][((long)(sb * 16 + h) * 256 + pp) * 64 + d];
    ((bf16_t*)(ws + L2_KALL))[((long)(sb * 16 + h) * 1280 + 1024 + pp) * 64 + d] = f2bf(kv);
  }
  for (long i = gtid; i < 2l * 16 * 64 * 256; i += gn) {
    int pp = i & 255; long r = i >> 8; int dv = r & 63; r >>= 6; int h = r & 15; int sb = r >> 4;
    float vv = p.in[7][((long)(sb * 16 + h) * 256 + pp) * 64 + dv];
    ((bf16_t*)(ws + L2_VTS))[((long)(sb * 16 + h) * 64 + dv) * 1280 + 1024 + pp] = f2bf(vv);
  }
}

__device__ __forceinline__ const float* xrow(const Params& p, int layer, int t) {
  if (layer == 0) return (t < TP_) ? p.in[0] + (long)t * 1024 : p.in[1] + (long)(t - TP_) * 1024;
  return p.out + (long)t * 1024;
}
struct F16 { float4 v[4]; };
__device__ __forceinline__ F16 norm_row(const Params& p, int layer, int t, int lane) {
  const float* x = xrow(p, layer, t);
  F16 h;
  float ss = 0.f;
#pragma unroll
  for (int it = 0; it < 4; ++it) {
    float4 v = *(const float4*)(x + it * 256 + lane * 4);
    h.v[it] = v;
    ss += v.x * v.x + v.y * v.y + v.z * v.z + v.w * v.w;
  }
  ss = wave_sum(ss);
  float rinv = rsqrtf(ss * (1.f / 1024.f) + 1e-6f);
  int cond = (t < TP_) ? 0 : 1 + ((t - TP_) >> 10);
  const float* mod = (const float*)(p.ws + OFF_MOD) + ((long)layer * 3 + cond) * 3072;
  const float* nw = p.in[10] + layer * 1024;
#pragma unroll
  for (int it = 0; it < 4; ++it) {
    int c = it * 256 + lane * 4;
    float4 w = *(const float4*)(nw + c);
    float4 sh = *(const float4*)(mod + c);
    float4 sc = *(const float4*)(mod + 1024 + c);
    h.v[it].x = h.v[it].x * rinv * w.x * (1.f + sc.x) + sh.x;
    h.v[it].y = h.v[it].y * rinv * w.y * (1.f + sc.y) + sh.y;
    h.v[it].z = h.v[it].z * rinv * w.z * (1.f + sc.z) + sh.z;
    h.v[it].w = h.v[it].w * rinv * w.w * (1.f + sc.w) + sh.w;
  }
  return h;
}
__device__ __forceinline__ void norm_phase(const Params& p, int layer) {
  const int lane = threadIdx.x & 63;
  const int gw = blockIdx.x * 4 + (threadIdx.x >> 6), nw = gridDim.x * 4;
  bf16_t* H = (bf16_t*)(p.ws + OFF_H);
  if (layer != 1) {
    for (int t = gw; t < T_; t += nw) {
      F16 h = norm_row(p, layer, t, lane);
#pragma unroll
      for (int it = 0; it < 4; ++it)
        *(uint2*)(H + (long)t * 1024 + it * 256 + lane * 4) = make_uint2(pack2(h.v[it].x, h.v[it].y), pack2(h.v[it].z, h.v[it].w));
    }
  } else {
    const float* mu = p.in[18];
    for (int chunk = gw; chunk < T_ / 4; chunk += nw) {
      const int t0 = chunk * 4;
      const int L = (t0 < TP_) ? 256 : 1024;
      const int l0 = (t0 < TP_) ? (t0 & 255) : ((t0 - TP_) & 1023);
      const bool hasp = l0 > 0, hasn = (l0 + 4 < L);
      float rinv[6];
#pragma unroll
      for (int j = 0; j < 6; ++j) {
        const bool ok = (j == 0) ? hasp : ((j == 5) ? hasn : true);
        const float* x = xrow(p, layer, ok ? (t0 - 1 + j) : t0);
        float ss = 0.f;
#pragma unroll
        for (int it = 0; it < 4; ++it) {
          const float4 v = *(const float4*)(x + it * 256 + lane * 4);
          ss += v.x * v.x + v.y * v.y + v.z * v.z + v.w * v.w;
        }
        rinv[j] = ok ? rsqrtf(wave_sum(ss) * (1.f / 1024.f) + 1e-6f) : 0.f;
      }
      const int cond = (t0 < TP_) ? 0 : 1 + ((t0 - TP_) >> 10);
      const float* mod = (const float*)(p.ws + OFF_MOD) + ((long)layer * 3 + cond) * 3072;
      const float* nwp = p.in[10] + layer * 1024;
#pragma unroll
      for (int it = 0; it < 4; ++it) {
        const int c = it * 256 + lane * 4;
        const float4 w = *(const float4*)(nwp + c);
        const float4 sh = *(const float4*)(mod + c);
        const float4 sc = *(const float4*)(mod + 1024 + c);
        const float4 ws4 = make_float4(w.x * (1.f + sc.x), w.y * (1.f + sc.y), w.z * (1.f + sc.z), w.w * (1.f + sc.w));
        float4 hr0, hr1, hr2, hr3, hr4, hr5;
#define NROW(dst, j)                                                                            \
        {                                                                                       \
          const bool ok = ((j) == 0) ? hasp : (((j) == 5) ? hasn : true);                        \
          const float4 v = *(const float4*)(xrow(p, layer, ok ? (t0 - 1 + (j)) : t0) + c);       \
          const float ri = rinv[j];                                                              \
          dst = ok ? make_float4(v.x * ri * ws4.x + sh.x, v.y * ri * ws4.y + sh.y, v.z * ri * ws4.z + sh.z, v.w * ri * ws4.w + sh.w) \
                   : make_float4(0.f, 0.f, 0.f, 0.f);                                            \
        }
        NROW(hr0, 0) NROW(hr1, 1) NROW(hr2, 2) NROW(hr3, 3) NROW(hr4, 4) NROW(hr5, 5)
#undef NROW
#define MIX1(ha, hh, hb, j)                                                                      \
          {                                                                                      \
            float x0 = hh.x + (0.5f * (ha.x + hb.x) - hh.x) * m.x;                               \
            float x1 = hh.y + (0.5f * (ha.y + hb.y) - hh.y) * m.y;                               \
            float x2 = hh.z + (0.5f * (ha.z + hb.z) - hh.z) * m.z;                               \
            float x3 = hh.w + (0.5f * (ha.w + hb.w) - hh.w) * m.w;                               \
            *(uint2*)(dst + (long)(t0 + (j)) * 1024 + c) = make_uint2(pack2(x0, x1), pack2(x2, x3)); \
          }
#pragma unroll
        for (int n = 0; n < 6; ++n) {
          bf16_t* dst = (n == 0) ? (bf16_t*)(p.ws + L1_XM) : (n == 2) ? (bf16_t*)(p.ws + L1_XM + 20 * MIB) : (n == 3) ? (bf16_t*)(p.ws + L1_XM + 40 * MIB)
                      : (n == 5) ? (bf16_t*)(p.ws + L1_XM + 60 * MIB) : (n == 1) ? (bf16_t*)(p.ws + L1_XW) : (bf16_t*)(p.ws + L1_XW + 20 * MIB);
          const float4 m = *(const float4*)(mu + n * 1024 + c);
          MIX1(hr0, hr1, hr2, 0)
          MIX1(hr1, hr2, hr3, 1)
          MIX1(hr2, hr3, hr4, 2)
          MIX1(hr3, hr4, hr5, 3)
        }
#undef MIX1
      }
    }
  }
}

__device__ __forceinline__ void final_norm_phase(const Params& p) {
  const int lane = threadIdx.x & 63;
  const int gw = blockIdx.x * 4 + (threadIdx.x >> 6), nw = gridDim.x * 4;
  const float* fw = p.in[13];
  for (int t = gw; t < T_; t += nw) {
    float* x = p.out + (long)t * 1024;
    float4 v[4];
    float ss = 0.f;
#pragma unroll
    for (int it = 0; it < 4; ++it) {
      v[it] = *(const float4*)(x + it * 256 + lane * 4);
      ss += v[it].x * v[it].x + v[it].y * v[it].y + v[it].z * v[it].z + v[it].w * v[it].w;
    }
    ss = wave_sum(ss);
    float rinv = rsqrtf(ss * (1.f / 1024.f) + 1e-6f);
#pragma unroll
    for (int it = 0; it < 4; ++it) {
      float4 w = *(const float4*)(fw + it * 256 + lane * 4);
      *(float4*)(x + it * 256 + lane * 4) = make_float4(v[it].x * rinv * w.x, v[it].y * rinv * w.y, v[it].z * rinv * w.z, v[it].w * rinv * w.w);
    }
  }
}

__device__ __forceinline__ void ret_ln_phase(const Params& p) {
  const int lane = threadIdx.x & 63;
  const int gw = blockIdx.x * 4 + (threadIdx.x >> 6), nw = gridDim.x * 4;
  const bf16_t* O = (const bf16_t*)(p.ws + L0_O);
  const bf16_t* G = (const bf16_t*)(p.ws + L0_G);
  bf16_t* OB = (bf16_t*)(p.ws + OFF_OB);
  const float* gn = p.in[16];
  for (int item = gw; item < T_ * 4; item += nw) {
    long base = (long)item * 512 + lane * 8;
    const uint4 oh = *(const uint4*)(O + base);
    float4 a = make_float4(bf2f(oh.x & 0xffff), bf2f(oh.x >> 16), bf2f(oh.y & 0xffff), bf2f(oh.y >> 16));
    float4 b = make_float4(bf2f(oh.z & 0xffff), bf2f(oh.z >> 16), bf2f(oh.w & 0xffff), bf2f(oh.w >> 16));
    float s = a.x + a.y + a.z + a.w + b.x + b.y + b.z + b.w;
    float mean = wave_sum(s) * (1.f / 512.f);
    a.x -= mean; a.y -= mean; a.z -= mean; a.w -= mean; b.x -= mean; b.y -= mean; b.z -= mean; b.w -= mean;
    float vs = a.x * a.x + a.y * a.y + a.z * a.z + a.w * a.w + b.x * b.x + b.y * b.y + b.z * b.z + b.w * b.w;
    float rinv = rsqrtf(wave_sum(vs) * (1.f / 512.f) + 1e-5f);
    int col = (item & 3) * 512 + lane * 8;
    uint4 gg = *(const uint4*)(G + base);
    float4 w0 = *(const float4*)(gn + col), w1 = *(const float4*)(gn + col + 4);
    uint4 o;
    o.x = pack2(a.x * rinv * w0.x * silu_f(bf2f(gg.x & 0xffff)), a.y * rinv * w0.y * silu_f(bf2f(gg.x >> 16)));
    o.y = pack2(a.z * rinv * w0.z * silu_f(bf2f(gg.y & 0xffff)), a.w * rinv * w0.w * silu_f(bf2f(gg.y >> 16)));
    o.z = pack2(b.x * rinv * w1.x * silu_f(bf2f(gg.z & 0xffff)), b.y * rinv * w1.y * silu_f(bf2f(gg.z >> 16)));
    o.w = pack2(b.z * rinv * w1.z * silu_f(bf2f(gg.w & 0xffff)), b.w * rinv * w1.w * silu_f(bf2f(gg.w >> 16)));
    *(uint4*)(OB + base) = o;
  }
}

__device__ __forceinline__ float dpp_xor1(float x) {
  return __builtin_bit_cast(float, __builtin_amdgcn_mov_dpp(__builtin_bit_cast(int, x), 0xB1, 0xF, 0xF, true));
}
__device__ __forceinline__ float dpp_xor2(float x) {
  return __builtin_bit_cast(float, __builtin_amdgcn_mov_dpp(__builtin_bit_cast(int, x), 0x4E, 0xF, 0xF, true));
}
__device__ __forceinline__ float dpp_hmirror(float x) {
  return __builtin_bit_cast(float, __builtin_amdgcn_mov_dpp(__builtin_bit_cast(int, x), 0x141, 0xF, 0xF, true));
}
__device__ __forceinline__ float red8(float x) {
  x += dpp_xor1(x);
  x += dpp_xor2(x);
  x += dpp_hmirror(x);
  return x;
}
template <int R>
__device__ __forceinline__ void rwkv_scan_item(const Params& p, int sample, int bb, int h, int dir, int half, char* smem) {
  char* ws = p.ws;
  float* sm = (float*)smem;
  const int tid = threadIdx.x;
  int L = sample ? 1024 : 256;
  int tok0 = sample ? TP_ + bb * 1024 : bb * 256;
  const int rp = tid >> 3, kq = tid & 7;
  const int row0 = (R == 2) ? 2 * rp : half * 32 + rp;
  v2f P[8];
#pragma unroll
  for (int i = 0; i < 8; ++i) P[i] = (v2f)(0.f);
  if (sample) {
    const float* s0 = p.in[3] + (((long)(bb * 2 + dir) * 16 + h) * 64 + row0) * 64 + kq * 8;
    if (R == 2) {
#pragma unroll
      for (int i = 0; i < 8; ++i) { P[i].x = s0[i]; P[i].y = s0[64 + i]; }
    } else {
#pragma unroll
      for (int j = 0; j < 4; ++j) { P[j].x = s0[2 * j]; P[j].y = s0[2 * j + 1]; }
    }
  }
  const bf16_t* RKVG = (const bf16_t*)(ws + L1_RKVG);
  const bf16_t* DEC = (const bf16_t*)(ws + L1_DEC) + (long)dir * T_ * 1024;
  const bf16_t* AA = (const bf16_t*)(ws + L1_AA) + (long)dir * T_ * 1024;
  float* Y = (float*)(ws + L1_Y) + (long)dir * T_ * 1024;
  const int ch = tid & 63, col = h * 64 + ch, sw = tid >> 6;
  const float kkw = p.in[26][col];
  const float kaw = p.in[27][col];
  const int nch = L >> 4;
  float rr[4], rk[4], rv[4], rwd[4], ra[4];
#define SCAN_LOAD(c)                                                        \
  _Pragma("unroll") for (int i = 0; i < 4; ++i) {                           \
    int pos = (c) * 16 + sw + i * 4;                                        \
    int t = dir ? (L - 1 - pos) : pos;                                      \
    long tok = tok0 + t;                                                    \
    rr[i] = bf2f(RKVG[tok * 4096 + col]);                                   \
    rk[i] = bf2f(RKVG[tok * 4096 + 1024 + col]);                            \
    rv[i] = bf2f(RKVG[tok * 4096 + 2048 + col]);                            \
    rwd[i] = __expf(-bf2f(DEC[tok * 1024 + col]));                          \
    ra[i] = bf2f(AA[tok * 1024 + col]);                                     \
  }
#define SCAN_PREP(buf)                                                      \
  _Pragma("unroll") for (int i = 0; i < 4; ++i) {                           \
    float* b = sm + (buf) * 6144 + (sw + i * 4) * 64 + ch;                  \
    float kkr = rk[i] * kkw;                                                \
    float ss = wave_sum(kkr * kkr);                                         \
    float kk = kkr * rsqrtf(fmaxf(ss, 1e-12f));                             \
    b[0] = rr[i]; b[1024] = rwd[i]; b[2048] = kk; b[3072] = kk * ra[i];     \
    b[4096] = rk[i] * (1.f + (ra[i] - 1.f) * kaw); b[5120] = rv[i];         \
  }
#define YFLUSH(cc)                                                                   \
  {                                                                                  \
    constexpr int QPR = (R == 2) ? 16 : 8;                     \
    if (tid < 16 * QPR) {                                                            \
      const int s_ = tid / QPR, q_ = tid - s_ * QPR;                                 \
      const int pos_ = (cc) * 16 + s_;                                               \
      const int t_ = dir ? (L - 1 - pos_) : pos_;                                    \
      const float4 yv = *(const float4*)(sm + 12288 + ((cc) & 1) * 1024 + s_ * 64 + q_ * 4); \
      *(float4*)(Y + (long)(tok0 + t_) * 1024 + h * 64 + ((R == 2) ? 0 : half * 32) + q_ * 4) = yv; \
    }                                                                                \
  }
  __syncthreads();
  SCAN_LOAD(0)
  SCAN_PREP(0)
  for (int c = 0; c < nch; ++c) {
    const int buf = c & 1;
    if (c + 1 < nch) SCAN_LOAD(c + 1)
    __syncthreads();
    if (c > 0) YFLUSH(c - 1)
    const float* bs = sm + buf * 6144;
    float4 n_kk0, n_kk1, n_w0, n_w1, n_ka0, n_ka1, n_kd0, n_kd1, n_r0, n_r1; float n_vx, n_vy = 0.f;
#define STEP_LOAD(s)                                                              \
    {                                                                             \
      const float* o = bs + (s) * 64 + kq * 8;                                    \
      n_kk0 = *(const float4*)(o + 2048); n_kk1 = *(const float4*)(o + 2052);     \
      n_w0 = *(const float4*)(o + 1024); n_w1 = *(const float4*)(o + 1028);       \
      n_ka0 = *(const float4*)(o + 3072); n_ka1 = *(const float4*)(o + 3076);     \
      n_kd0 = *(const float4*)(o + 4096); n_kd1 = *(const float4*)(o + 4100);     \
      n_r0 = *(const float4*)(o); n_r1 = *(const float4*)(o + 4);                 \
      if (R == 2) { const float2 vv = *(const float2*)(bs + 5120 + (s) * 64 + row0); n_vx = vv.x; n_vy = vv.y; } \
      else n_vx = bs[5120 + (s) * 64 + row0];                                     \
    }
    STEP_LOAD(0)
#pragma unroll
    for (int s = 0; s < 16; ++s) {
      const float4 kka = n_kk0, kkb = n_kk1, wa = n_w0, wb = n_w1, ka = n_ka0, kb = n_ka1, da = n_kd0, db = n_kd1, ra4 = n_r0, rb4 = n_r1;
      const float vx = n_vx, vy = n_vy;
      if (s + 1 < 16) STEP_LOAD(s + 1)
      const float kkv[8] = {kka.x, kka.y, kka.z, kka.w, kkb.x, kkb.y, kkb.z, kkb.w};
      const float wv[8] = {wa.x, wa.y, wa.z, wa.w, wb.x, wb.y, wb.z, wb.w};
      const float kv[8] = {ka.x, ka.y, ka.z, ka.w, kb.x, kb.y, kb.z, kb.w};
      const float dv[8] = {da.x, da.y, da.z, da.w, db.x, db.y, db.z, db.w};
      const float rv8[8] = {ra4.x, ra4.y, ra4.z, ra4.w, rb4.x, rb4.y, rb4.z, rb4.w};
      float y0, y1 = 0.f;
      if (R == 2) {
        v2f dA = P[0] * (v2f)(kkv[0]), dB = P[1] * (v2f)(kkv[1]);
#pragma unroll
        for (int i = 2; i < 8; i += 2) { dA += P[i] * (v2f)(kkv[i]); dB += P[i + 1] * (v2f)(kkv[i + 1]); }
        const v2f d = dA + dB;
        v2f sa; sa.x = -red8(d.x); sa.y = -red8(d.y);
        v2f vv; vv.x = vx; vv.y = vy;
        v2f yA = (v2f)(0.f), yB = (v2f)(0.f);
#pragma unroll
        for (int i = 0; i < 8; i += 2) {
          P[i] = P[i] * (v2f)(wv[i]) + (sa * (v2f)(kv[i]) + vv * (v2f)(dv[i]));
          P[i + 1] = P[i + 1] * (v2f)(wv[i + 1]) + (sa * (v2f)(kv[i + 1]) + vv * (v2f)(dv[i + 1]));
          yA += P[i] * (v2f)(rv8[i]); yB += P[i + 1] * (v2f)(rv8[i + 1]);
        }
        const v2f yy = yA + yB;
        y0 = red8(yy.x); y1 = red8(yy.y);
      } else {
        v2f dA = P[0] * (v2f){kkv[0], kkv[1]} + P[2] * (v2f){kkv[4], kkv[5]};
        v2f dB = P[1] * (v2f){kkv[2], kkv[3]} + P[3] * (v2f){kkv[6], kkv[7]};
        const v2f d = dA + dB;
        const float sa = -red8(d.x + d.y);
        v2f yA = (v2f)(0.f), yB = (v2f)(0.f);
#pragma unroll
        for (int j = 0; j < 4; j += 2) {
          P[j] = P[j] * (v2f){wv[2 * j], wv[2 * j + 1]} + ((v2f)(sa) * (v2f){kv[2 * j], kv[2 * j + 1]} + (v2f)(vx) * (v2f){dv[2 * j], dv[2 * j + 1]});
          P[j + 1] = P[j + 1] * (v2f){wv[2 * j + 2], wv[2 * j + 3]} + ((v2f)(sa) * (v2f){kv[2 * j + 2], kv[2 * j + 3]} + (v2f)(vx) * (v2f){dv[2 * j + 2], dv[2 * j + 3]});
          yA += P[j] * (v2f){rv8[2 * j], rv8[2 * j + 1]}; yB += P[j + 1] * (v2f){rv8[2 * j + 2], rv8[2 * j + 3]};
        }
        const v2f yy = yA + yB;
        y0 = red8(yy.x + yy.y);
      }
      if (kq == 0) {
        float* yb = sm + 12288 + buf * 1024 + s * 64 + ((R == 2) ? 2 * rp : rp);
        if (R == 2) *(float2*)yb = make_float2(y0, y1);
        else *yb = y0;
      }
    }
#undef STEP_LOAD
    if (c + 1 < nch) SCAN_PREP(buf ^ 1)
  }
  __syncthreads();
  YFLUSH(nch - 1)
#undef YFLUSH
#undef SCAN_LOAD
#undef SCAN_PREP
  if (!sample) {
    float* so = p.out + OUT_STATE_RWKV + (((long)(bb * 2 + dir) * 16 + h) * 64 + row0) * 64 + kq * 8;
    if (R == 2) {
      *(float4*)(so) = make_float4(P[0].x, P[1].x, P[2].x, P[3].x);
      *(float4*)(so + 4) = make_float4(P[4].x, P[5].x, P[6].x, P[7].x);
      *(float4*)(so + 64) = make_float4(P[0].y, P[1].y, P[2].y, P[3].y);
      *(float4*)(so + 68) = make_float4(P[4].y, P[5].y, P[6].y, P[7].y);
    } else {
      *(float4*)(so) = make_float4(P[0].x, P[0].y, P[1].x, P[1].y);
      *(float4*)(so + 4) = make_float4(P[2].x, P[2].y, P[3].x, P[3].y);
    }
  }
}
__device__ __forceinline__ void deferred_transposes(const Params& p, char* smem, int worker, int nworkers) {
  int base = 0, tile = worker;
  for (int j = 4; j <= 7; ++j) {
    TJob t = tjob(p, j);
    int nt = (t.K >> 6) * (t.N >> 6);
    while (tile < base + nt) { transpose_tile(t, tile - base, smem); tile += nworkers; }
    base += nt;
  }
  __syncthreads();
}
__device__ __forceinline__ void rwkv_scan_phase(const Params& p, char* smem) {
  const int nb = gridDim.x, b = blockIdx.x;
  if (nb == 512) {
    if (b < 128) { int sc = b >> 1; rwkv_scan_item<1>(p, 1, sc >> 5, (sc >> 1) & 15, sc & 1, b & 1, smem); }
    else
      for (int it = b - 128; it < 1024; it += nb - 128) rwkv_scan_item<2>(p, 0, it >> 5, (it >> 1) & 15, it & 1, 0, smem);
    if (b < 128) { deferred_transposes(p, smem, b, 256); mod_gemv_items(p, smem, 384, 768, b, 256); }
    else if (b >= 384) { deferred_transposes(p, smem, 128 + (b - 384), 256); mod_gemv_items(p, smem, 384, 768, 128 + (b - 384), 256); }
  } else if (nb >= 256) {
    if (b < 128) { int sc = b >> 1; rwkv_scan_item<1>(p, 1, sc >> 5, (sc >> 1) & 15, sc & 1, b & 1, smem); }
    else
      for (int it = b - 128; it < 1024; it += nb - 128) rwkv_scan_item<2>(p, 0, it >> 5, (it >> 1) & 15, it & 1, 0, smem);
  } else {
    for (int it = b; it < 1088; it += nb) {
      if (it < 64) rwkv_scan_item<2>(p, 1, it >> 5, (it >> 1) & 15, it & 1, 0, smem);
      else { int i2 = it - 64; rwkv_scan_item<2>(p, 0, i2 >> 5, (i2 >> 1) & 15, i2 & 1, 0, smem); }
    }
  }
}
__device__ __forceinline__ float row_sum(float v) {
  v += DPPF(v, 0xB1);
  v += DPPF(v, 0x4E);
  v += DPPF(v, 0x141);
  v += DPPF(v, 0x140);
  return v;
}
__device__ __forceinline__ void rwkv_post_phase(const Params& p) {
  char* ws = p.ws;
  const int lane = threadIdx.x & 63;
  const int gw = blockIdx.x * 4 + (threadIdx.x >> 6), nw = gridDim.x * 4;
  const bf16_t* RKVG = (const bf16_t*)(ws + L1_RKVG);
  const bf16_t* AA = (const bf16_t*)(ws + L1_AA);
  const float* Y = (const float*)(ws + L1_Y);
  bf16_t* OB = (bf16_t*)(ws + OFF_OB);
  for (int item = gw; item < T_ * 4; item += nw) {
    const long t = item >> 2;
    const int c0 = (item & 3) * 256 + lane * 4;
    const uint2 r2 = *(const uint2*)(RKVG + t * 4096 + c0);
    const uint2 k2 = *(const uint2*)(RKVG + t * 4096 + 1024 + c0);
    const uint2 v2 = *(const uint2*)(RKVG + t * 4096 + 2048 + c0);
    const uint2 g2 = *(const uint2*)(RKVG + t * 4096 + 3072 + c0);
    const uint2 a0h = *(const uint2*)(AA + t * 1024 + c0);
    const uint2 a1h = *(const uint2*)(AA + (long)T_ * 1024 + t * 1024 + c0);
    const float4 y0 = *(const float4*)(Y + t * 1024 + c0);
    const float4 y1 = *(const float4*)(Y + (long)T_ * 1024 + t * 1024 + c0);
    const float4 ka = *(const float4*)(p.in[27] + c0);
    const float4 rk = *(const float4*)(p.in[28] + c0);
    const float4 gn = *(const float4*)(p.in[29] + c0);
    const float r[4] = {bf2f(r2.x & 0xffff), bf2f(r2.x >> 16), bf2f(r2.y & 0xffff), bf2f(r2.y >> 16)};
    const float k[4] = {bf2f(k2.x & 0xffff), bf2f(k2.x >> 16), bf2f(k2.y & 0xffff), bf2f(k2.y >> 16)};
    const float v[4] = {bf2f(v2.x & 0xffff), bf2f(v2.x >> 16), bf2f(v2.y & 0xffff), bf2f(v2.y >> 16)};
    const float g[4] = {bf2f(g2.x & 0xffff), bf2f(g2.x >> 16), bf2f(g2.y & 0xffff), bf2f(g2.y >> 16)};
    const float as[4] = {bf2f(a0h.x & 0xffff) + bf2f(a1h.x & 0xffff), bf2f(a0h.x >> 16) + bf2f(a1h.x >> 16),
                         bf2f(a0h.y & 0xffff) + bf2f(a1h.y & 0xffff), bf2f(a0h.y >> 16) + bf2f(a1h.y >> 16)};
    const float kav[4] = {ka.x, ka.y, ka.z, ka.w};
    const float rkv[4] = {rk.x, rk.y, rk.z, rk.w};
    const float gnv[4] = {gn.x, gn.y, gn.z, gn.w};
    float y[4] = {y0.x + y1.x, y0.y + y1.y, y0.z + y1.z, y0.w + y1.w};
    float bs = 0.f, ys = 0.f;
#pragma unroll
    for (int e = 0; e < 4; ++e) {
      bs += r[e] * (k[e] * (2.f + (as[e] - 2.f) * kav[e])) * rkv[e];
      ys += y[e];
    }
    const float bsum = row_sum(bs);
    const float mean = row_sum(ys) * (1.f / 64.f);
    float vs = 0.f;
#pragma unroll
    for (int e = 0; e < 4; ++e) { y[e] -= mean; vs += y[e] * y[e]; }
    const float rinv = rsqrtf(row_sum(vs) * (1.f / 64.f) + 1e-5f);
    float o[4];
#pragma unroll
    for (int e = 0; e < 4; ++e) o[e] = (y[e] * rinv * gnv[e] + bsum * v[e]) * silu_f(g[e]);
    *(uint2*)(OB + t * 1024 + c0) = make_uint2(pack2(o[0], o[1]), pack2(o[2], o[3]));
  }
}

__device__ __forceinline__ float diff_lambda(const Params& p, int lane, float lam_init) {
  const float* lp = p.in[32];
  float a = wave_sum(lp[lane] * lp[64 + lane]);
  float b = wave_sum(lp[128 + lane] * lp[192 + lane]);
  return __expf(a) - __expf(b) + lam_init;
}
#define LAM_INIT_2 0.47071302f

template <int NC, int DV, bool sample>
__device__ __forceinline__ void attn_item(const Params& p, int seq, int h, int qb, float lam, char* smem) {
  constexpr bool NA = (NC == 1);
  constexpr int KW = NC * 64;
  constexpr int NH = 1024 / KW;
  constexpr int KS = 72;
  constexpr int VS = 72;
  constexpr int NDT = DV / 16;
  constexpr int OSS = DV + 4;
  char* ws = p.ws;
  bf16_t* Ks = (bf16_t*)smem;
  bf16_t* Vs = Ks + 64 * KS;
  float* Os = (float*)(Vs + DV * VS);
  const int tid = threadIdx.x, lane = tid & 63, w = tid >> 6, l15 = lane & 15, q4 = lane >> 4;
  constexpr int Lk = sample ? 1280 : 256;
  const long tok0 = sample ? (long)TP_ + seq * 1024 : (long)seq * 256;
  const long q_tok = tok0 + qb * 64 + w * 16 + l15;
  constexpr int kstride = sample ? KW : 1024;
  const bf16_t* Kb = sample ? (const bf16_t*)(ws + L2_KALL) + (long)(seq * NH + h) * 1280 * KW
                            : (const bf16_t*)(ws + L2_KP) + tok0 * 1024 + h * KW;
  const bf16_t* Vb = sample ? (const bf16_t*)(ws + L2_VTS) + (long)(seq * NH + h) * DV * 1280
                            : (const bf16_t*)(ws + L2_VTP) + (long)(seq * NH + h) * DV * 256;
  const int rs = min(max(qb - 4, 0), 8);
  const int qc = w * 16 + l15;
  const int cs = min(max(qc - 8, 0), 48);
  const float* bt = p.in[36] + h * 465;
  constexpr int ntiles = (NA && sample) ? 12 : (Lk >> 6);
  f32x4 O[NDT];
  float lsum = 0.f;
  bf16x8 qf[2];
  float mrun = -INFINITY, lrun = 0.f;
  constexpr int npass = NC * ntiles;
  uint4 kr0, kr1, vr0, vr1, vr2 = make_uint4(0, 0, 0, 0), vr3 = make_uint4(0, 0, 0, 0);
  const int ldrow = tid >> 3, ldch = tid & 7;
#define ATT_LOAD(pi)                                                                                   \
  {                                                                                                    \
    const int c_ = (pi) / ntiles, ti_ = (pi) - c_ * ntiles;                                            \
    const int kt_ = (NA && sample) ? (ti_ < 8 ? rs + ti_ : 8 + ti_) : ti_;                             \
    const int key0_ = kt_ * 64;                                                                        \
    kr0 = *(const uint4*)(Kb + (long)(key0_ + ldrow) * kstride + c_ * 64 + ldch * 8);                  \
    kr1 = *(const uint4*)(Kb + (long)(key0_ + ldrow + 32) * kstride + c_ * 64 + ldch * 8);             \
    vr0 = *(const uint4*)(Vb + (long)ldrow * Lk + key0_ + ldch * 8);                                   \
    vr1 = *(const uint4*)(Vb + (long)(ldrow + 32) * Lk + key0_ + ldch * 8);                            \
    if (DV > 64) {                                                                                     \
      vr2 = *(const uint4*)(Vb + (long)(ldrow + 64) * Lk + key0_ + ldch * 8);                          \
      vr3 = *(const uint4*)(Vb + (long)(ldrow + 96) * Lk + key0_ + ldch * 8);                          \
    }                                                                                                  \
  }
  ATT_LOAD(0)
#pragma unroll 1
  for (int pi = 0; pi < npass; ++pi) {
    const int c = pi / ntiles, ti = pi - c * ntiles;
    if (ti == 0) {
      const bf16_t* Q = (const bf16_t*)(ws + L2_Q) + q_tok * 1024 + h * KW + c * 64;
      qf[0] = *(const bf16x8*)(Q + q4 * 8);
      qf[1] = *(const bf16x8*)(Q + 32 + q4 * 8);
      mrun = -INFINITY; lrun = 0.f;
#pragma unroll
      for (int dt = 0; dt < NDT; ++dt) O[dt] = (f32x4){0.f, 0.f, 0.f, 0.f};
    }
    const int kt = (NA && sample) ? (ti < 8 ? rs + ti : 8 + ti) : ti;
    __syncthreads();
    *(uint4*)(Ks + ldrow * KS + ldch * 8) = kr0;
    *(uint4*)(Ks + (ldrow + 32) * KS + ldch * 8) = kr1;
    *(uint4*)(Vs + ldrow * VS + ldch * 8) = vr0;
    *(uint4*)(Vs + (ldrow + 32) * VS + ldch * 8) = vr1;
    if (DV > 64) {
      *(uint4*)(Vs + (ldrow + 64) * VS + ldch * 8) = vr2;
      *(uint4*)(Vs + (ldrow + 96) * VS + ldch * 8) = vr3;
    }
    __syncthreads();
    if (pi + 1 < npass) ATT_LOAD(pi + 1)
    {
      f32x4 s[4];
#pragma unroll
      for (int st = 0; st < 4; ++st) {
        s[st] = (f32x4){0.f, 0.f, 0.f, 0.f};
#pragma unroll
        for (int ks = 0; ks < 2; ++ks) {
          bf16x8 a = *(const bf16x8*)(Ks + (st * 16 + l15) * KS + ks * 32 + q4 * 8);
          s[st] = __builtin_amdgcn_mfma_f32_16x16x32_f16(a, qf[ks], s[st], 0, 0, 0);
        }
      }
      float mx = -INFINITY;
#pragma unroll
      for (int st = 0; st < 4; ++st)
#pragma unroll
        for (int j = 0; j < 4; ++j) {
          float val = s[st][j] * 0.125f;
          if (NA && sample && kt < 16) {
            int kc = st * 16 + q4 * 4 + j;
            bool ok = (kc >= cs) && (kc < cs + 16);
            int ro = kt - qb + 7;
            int co = min(max(kc - qc, -15), 15) + 15;
            val = ok ? val + bt[ro * 31 + co] : -INFINITY;
          }
          s[st][j] = val;
          mx = fmaxf(mx, val);
        }
      mx = fmaxf(mx, __shfl_xor(mx, 16));
      mx = fmaxf(mx, __shfl_xor(mx, 32));
      const float mnew = fmaxf(mrun, mx);
      const float alpha = __expf(mrun - mnew);
      mrun = mnew;
      float psum = 0.f;
#pragma unroll
      for (int st = 0; st < 4; ++st)
#pragma unroll
        for (int j = 0; j < 4; ++j) {
          float pv = __expf(s[st][j] - mnew);
          s[st][j] = pv;
          psum += pv;
        }
      lrun = lrun * alpha + psum;
#pragma unroll
      for (int dt = 0; dt < NDT; ++dt) {
        O[dt][0] *= alpha; O[dt][1] *= alpha; O[dt][2] *= alpha; O[dt][3] *= alpha;
      }
#pragma unroll
      for (int pp = 0; pp < 2; ++pp) {
        bf16x8 pf;
#pragma unroll
        for (int j = 0; j < 4; ++j) { pf[j] = (_Float16)s[2 * pp][j]; pf[4 + j] = (_Float16)s[2 * pp + 1][j]; }
#pragma unroll
        for (int dt = 0; dt < NDT; ++dt) {
          const bf16_t* vr = Vs + (dt * 16 + l15) * VS + pp * 32 + q4 * 4;
          uint2 lo = *(const uint2*)vr, hi = *(const uint2*)(vr + 16);
          uint4 av = make_uint4(lo.x, lo.y, hi.x, hi.y);
          O[dt] = __builtin_amdgcn_mfma_f32_16x16x32_f16(__builtin_bit_cast(bf16x8, av), pf, O[dt], 0, 0, 0);
        }
      }
    }
    if (ti == ntiles - 1) {
      lrun += __shfl_xor(lrun, 16);
      lrun += __shfl_xor(lrun, 32);
      lsum = lrun;
      if (!NA && c == 0) {
        const float il = __builtin_amdgcn_rcpf(lrun);
        float* os = Os + (w * 16 + l15) * OSS + q4 * 4;
#pragma unroll
        for (int dt = 0; dt < NDT; ++dt)
          *(float4*)(os + dt * 16) = make_float4(O[dt][0] * il, O[dt][1] * il, O[dt][2] * il, O[dt][3] * il);
      }
    }
  }
#undef ATT_LOAD
  const bf16_t* G = (const bf16_t*)(ws + L2_G) + q_tok * 1024 + h * DV;
  bf16_t* OB = (bf16_t*)(ws + OFF_OB) + q_tok * 1024 + h * DV;
  if (NA) {
    const float il = __builtin_amdgcn_rcpf(lsum);
#pragma unroll
    for (int dt = 0; dt < NDT; ++dt) {
      int dv = dt * 16 + q4 * 4;
      uint2 gg = *(const uint2*)(G + dv);
      float g0 = bf2f(gg.x & 0xffff), g1 = bf2f(gg.x >> 16), g2 = bf2f(gg.y & 0xffff), g3 = bf2f(gg.y >> 16);
      *(uint2*)(OB + dv) = make_uint2(pack2(O[dt][0] * il * silu_f(g0), O[dt][1] * il * silu_f(g1)),
                                      pack2(O[dt][2] * il * silu_f(g2), O[dt][3] * il * silu_f(g3)));
    }
  } else {
    const float i1 = lam * __builtin_amdgcn_rcpf(lsum);
    const float* os = Os + (w * 16 + l15) * OSS + q4 * 4;
    float ss = 0.f;
#pragma unroll
    for (int dt = 0; dt < NDT; ++dt) {
      float4 o0 = *(const float4*)(os + dt * 16);
      O[dt][0] = o0.x - O[dt][0] * i1; O[dt][1] = o0.y - O[dt][1] * i1;
      O[dt][2] = o0.z - O[dt][2] * i1; O[dt][3] = o0.w - O[dt][3] * i1;
      ss += O[dt][0] * O[dt][0] + O[dt][1] * O[dt][1] + O[dt][2] * O[dt][2] + O[dt][3] * O[dt][3];
    }
    ss += __shfl_xor(ss, 16);
    ss += __shfl_xor(ss, 32);
    const float rinv = rsqrtf(ss * (1.f / DV) + 1e-6f) * (1.f - LAM_INIT_2);
    const float* gn = p.in[33] + h * DV;
#pragma unroll
    for (int dt = 0; dt < NDT; ++dt) {
      int dv = dt * 16 + q4 * 4;
      uint2 gg = *(const uint2*)(G + dv);
      float4 gw = *(const float4*)(gn + dv);
      float g0 = bf2f(gg.x & 0xffff), g1 = bf2f(gg.x >> 16), g2 = bf2f(gg.y & 0xffff), g3 = bf2f(gg.y >> 16);
      *(uint2*)(OB + dv) = make_uint2(pack2(O[dt][0] * rinv * gw.x * silu_f(g0), O[dt][1] * rinv * gw.y * silu_f(g1)),
                                      pack2(O[dt][2] * rinv * gw.z * silu_f(g2), O[dt][3] * rinv * gw.w * silu_f(g3)));
    }
  }
}
__device__ __forceinline__ void diff_attn_phase(const Params& p, char* smem) {
  const int lane = threadIdx.x & 63;
  const float lam = diff_lambda(p, lane, LAM_INIT_2);
  const int b = blockIdx.x, nb = gridDim.x;
  const bool split = nb >= 512;
  int it = split ? (b < 256 ? b : 256 + (b - 256)) : b;
  const int step = split ? (b < 256 ? 1 << 30 : nb - 256) : nb;
  for (; it < 1280; it += step) {
    bool sample = it < 256;
    int i2 = sample ? it : it - 256;
    int seq = sample ? (i2 >> 7) : (i2 >> 5);
    int h = sample ? ((i2 >> 4) & 7) : ((i2 >> 2) & 7);
    int qb = sample ? (i2 & 15) : (i2 & 3);
    if (sample) attn_item<2, 128, true>(p, seq, h, qb, lam, smem);
    else attn_item<2, 128, false>(p, seq, h, qb, lam, smem);
    if (step == (1 << 30)) break;
  }
}
__device__ __forceinline__ void na_attn_phase(const Params& p, char* smem) {
  const int b = blockIdx.x, nb = gridDim.x;
  for (int it = b; it < 2560; it += nb) {
    bool sample = it < 512;
    int i2 = sample ? it : it - 512;
    int seq = sample ? (i2 >> 8) : (i2 >> 6);
    int h = sample ? ((i2 >> 4) & 15) : ((i2 >> 2) & 15);
    int qb = sample ? (i2 & 15) : (i2 & 3);
    if (sample) attn_item<1, 64, true>(p, seq, h, qb, 0.f, smem);
    else attn_item<1, 64, false>(p, seq, h, qb, 0.f, smem);
  }
}

#define OFF_BAR (512l * 1024)
#define XB_TMO      128
#define XB_XCNT(j)  (256  + 64 * (j))
#define XB_XSUB(j)  (1280 + 64 * (j))
#define XB_XGEN(j)  (2304 + 64 * (j))
#define XB_TOP      3328
#define XB_TOPGEN   3392
#define XB_RANK(j)  (3456 + 64 * (j))
#define XCD_BAR_WORDS 4480
#define XB_SPIN_CAP (1u << 20)
#define LAS __attribute__((address_space(3)))
__device__ __forceinline__ unsigned xb_ld(unsigned* p)              { return __hip_atomic_load(p, __ATOMIC_RELAXED, __HIP_MEMORY_SCOPE_AGENT); }
__device__ __forceinline__ unsigned xb_add(unsigned* p, unsigned v) { return __hip_atomic_fetch_add(p, v, __ATOMIC_RELAXED, __HIP_MEMORY_SCOPE_AGENT); }
__device__ __forceinline__ unsigned xb_xcc_id() { return (unsigned)__builtin_amdgcn_s_getreg((3 << 11) | 20) & 0xFu; }
#define XB_SPIN(cond, bar) do { unsigned _sp = 0; while (cond) { __builtin_amdgcn_s_sleep(1); \
    if ((++_sp & 255u) == 0u) { if (xb_ld(&(bar)[XB_TMO])) break; if (_sp > XB_SPIN_CAP) { atomicAdd(&(bar)[XB_TMO], 1u); break; } } } } while (0)
struct XcdBarrier { unsigned* bar; unsigned x; volatile LAS unsigned* st; };
__device__ __forceinline__ XcdBarrier xcd_barrier_post(unsigned* bar, volatile LAS unsigned* st) {
  XcdBarrier b; b.bar = bar; b.x = xb_xcc_id(); b.st = st;
  if (threadIdx.x == 0) (void)xb_add(&bar[XB_XCNT(b.x)], 1u);
  return b;
}
__device__ __forceinline__ void xcd_barrier_complete(unsigned* bar, unsigned x, unsigned& nloc, unsigned& nx) {
  const unsigned G = gridDim.x * gridDim.y * gridDim.z;
  unsigned sum, cnt, mine, sp = 0u;
  for (;;) {
    sum = 0u; cnt = 0u; mine = 0u;
#pragma unroll
    for (unsigned j = 0; j < 16; ++j) { const unsigned c = xb_ld(&bar[XB_XCNT(j)]); sum += c; cnt += (c > 0u) ? 1u : 0u; mine = (j == x) ? c : mine; }
    if (sum == G) break;
    __builtin_amdgcn_s_sleep(1);
    if ((++sp & 255u) == 0u) { if (xb_ld(&bar[XB_TMO])) break; if (sp > XB_SPIN_CAP) { atomicAdd(&bar[XB_TMO], 1u); break; } }
  }
  nloc = mine > 0u ? mine : 1u; nx = cnt > 0u ? cnt : 1u;
}
__device__ __forceinline__ void xcd_barrier(const XcdBarrier& b) {
  asm volatile("s_waitcnt vmcnt(0)" ::: "memory");
  __syncthreads();
  if (threadIdx.x == 0) {
    unsigned* bar = b.bar;
    __builtin_amdgcn_s_waitcnt(0);
    unsigned nloc = b.st[0], nx = b.st[1];
    if (nloc == 0u) { xcd_barrier_complete(bar, b.x, nloc, nx); b.st[0] = nloc; b.st[1] = nx; }
    const unsigned old = xb_add(&bar[XB_XSUB(b.x)], 1u);
    const unsigned gen = old / nloc;
    if (old + 1u == (gen + 1u) * nloc) {
      __builtin_amdgcn_fence(__ATOMIC_RELEASE, "agent");
      asm volatile("s_waitcnt vmcnt(0)" ::: "memory");
      const unsigned og = xb_add(&bar[XB_TOP], 1u);
      const unsigned tg = og / nx;
      if (og + 1u == (tg + 1u) * nx) xb_add(&bar[XB_TOPGEN], 1u);
      else XB_SPIN(xb_ld(&bar[XB_TOPGEN]) == tg, bar);
      __builtin_amdgcn_fence(__ATOMIC_ACQUIRE, "agent");
      xb_add(&bar[XB_XGEN(b.x)], 1u);
      asm volatile("s_waitcnt vmcnt(0)" ::: "memory");
    } else {
      XB_SPIN(xb_ld(&bar[XB_XGEN(b.x)]) == gen, bar);
      __builtin_amdgcn_fence(__ATOMIC_ACQUIRE, "agent");
      asm volatile("s_waitcnt vmcnt(0)" ::: "memory");
    }
  }
  __syncthreads();
}

#define N_PHASES 27
#define N_PHASES 22
#define GSYNC(k) { xcd_barrier(xb); }
#define PH(k, body)                                   \
  if (ph_lo <= (k) && (k) < ph_hi) { body; }          \
  if (ph_lo <= (k) && (k) + 1 < ph_hi) GSYNC(k)
__global__ void __launch_bounds__(256, 2) mega(Params p, int ph_lo, int ph_hi) {
  __shared__ __attribute__((aligned(16))) char smem[73728];
  __shared__ uint4 xb_words;
  cg::grid_group grid = cg::this_grid();
  unsigned* bar = (unsigned*)(p.ws + OFF_BAR);
  if (threadIdx.x == 0) xb_words = make_uint4(0u, 0u, 0u, 0u);
  __syncthreads();
  if (ph_lo < 0) grid.sync();
  XcdBarrier xb = xcd_barrier_post(bar, (volatile LAS unsigned*)&xb_words);
  int vb = blockIdx.x;
  PH(0, prep_phase(p, smem))
  PH(1, norm_phase(p, 0))
  PH(2, gemm_phase(p, 0, smem, vb); if (gridDim.x == 512) { transposes_subset(p, smem, 0xFF0Eu, blockIdx.x, 512); mod_gemv_items(p, smem, 192, 384, blockIdx.x, 512); ret_s0_prep(p); })
  PH(3, gemm_phase(p, 1, smem, vb))
  PH(4, gemm_phase(p, 2, smem, vb))
  PH(5, ret_ln_phase(p))
  PH(6, gemm_phase(p, 3, smem, vb))
  PH(7, norm_phase(p, 1))
  PH(8, gemm_phase(p, 4, smem, vb))
  PH(9, gemm_phase(p, 5, smem, vb))
  PH(10, rwkv_scan_phase(p, smem))
  PH(11, rwkv_post_phase(p))
  PH(12, gemm_phase(p, 6, smem, vb))
  PH(13, norm_phase(p, 2); diff_cache_prep(p))
  PH(14, gemm_phase(p, 7, smem, vb))
  PH(15, diff_attn_phase(p, smem))
  PH(16, gemm_phase(p, 10, smem, vb))
  PH(17, norm_phase(p, 3); na_cache_prep(p))
  PH(18, gemm_phase(p, 11, smem, vb))
  PH(19, na_attn_phase(p, smem))
  PH(20, gemm_phase(p, 14, smem, vb))
  PH(21, final_norm_phase(p))
}

extern "C" void kernel_launch(void* const* d_in, const int* in_sizes, int n_in,
                              void* d_out, int out_size, void* d_ws, size_t ws_size,
                              hipStream_t stream) {
  static int grid_blocks = 0;
  if (!grid_blocks) {
    int dev = 0, cus = 0, per_cu = 0;
    (void)hipGetDevice(&dev);
    (void)hipDeviceGetAttribute(&cus, hipDeviceAttributeMultiprocessorCount, dev);
    (void)hipOccupancyMaxActiveBlocksPerMultiprocessor(&per_cu, mega, 256, 0);
    if (per_cu > 2) per_cu = 2;
    if (per_cu < 1) per_cu = 1;
    grid_blocks = cus * per_cu;
  }
  Params p{};
  for (int i = 0; i < 38; ++i) p.in[i] = (const float*)d_in[i];
  p.out = (float*)d_out;
  p.ws = (char*)d_ws;
  int lo = 0, hi = N_PHASES;
  (void)hipMemsetAsync((char*)d_ws + OFF_BAR, 0, XCD_BAR_WORDS * 4, stream);
  void* args[] = {&p, &lo, &hi};
  hipError_t e = hipLaunchCooperativeKernel((void*)mega, dim3(grid_blocks), dim3(256), args, 0, stream);
  if (e != hipSuccess) fprintf(stderr, "cooperative launch failed: %s (grid %d)\n", hipGetErrorString(e), grid_blocks);
}
```

```cpp
#include <hip/hip_runtime.h>
#include <hip/hip_cooperative_groups.h>
#include <cstdio>
namespace cg = cooperative_groups;

typedef unsigned short bf16_t;
using bf16x8 = __attribute__((ext_vector_type(8))) _Float16;
using f32x4 = __attribute__((ext_vector_type(4))) float;
typedef float v2f __attribute__((ext_vector_type(2)));

#define TP_ 8192
#define T_ 10240
#define MIB (1l << 20)

#define OFF_MOD 0l
#define OFF_TAB (256l * 1024)
#define OFF_WT_RET_IN (1 * MIB)
#define OFF_WT_RET_OUT (13 * MIB)
#define OFF_WT_RWKV_IN (17 * MIB)
#define OFF_WT_RWKV_OUT (25 * MIB)
#define OFF_WT_DIFF_IN (27 * MIB)
#define OFF_WT_DIFF_OUT (35 * MIB)
#define OFF_WT_NA_IN (37 * MIB)
#define OFF_WT_NA_OUT (45 * MIB)
#define OFF_WT_LDOWN (47 * MIB)
#define OFF_WT_LUP (47 * MIB + 512 * 1024)
#define ARENA (48 * MIB)
#define OFF_H (ARENA + 0 * MIB)
#define OFF_SH (ARENA + 20 * MIB)
#define OFF_OB (ARENA + 40 * MIB)
#define L0_Q (ARENA + 80 * MIB)
#define L0_K (ARENA + 100 * MIB)
#define L0_G (ARENA + 120 * MIB)
#define L0_VTP (ARENA + 160 * MIB)
#define L0_VTS (ARENA + 192 * MIB)
#define L0_KT (ARENA + 208 * MIB)
#define L0_SP (ARENA + 240 * MIB)
#define L0_PEXT (ARENA + 256 * MIB)
#define L0_O (ARENA + 280 * MIB)
#define L1_RKVG (ARENA + 80 * MIB)
#define L1_L (ARENA + 160 * MIB)
#define L1_DEC (ARENA + 168 * MIB)
#define L1_AA (ARENA + 248 * MIB)
#define L1_Y (ARENA + 328 * MIB)
#define L1_XM (ARENA + 0 * MIB)
#define L1_XW (ARENA + 328 * MIB)
#define L2_O (ARENA + 0 * MIB)
#define L2_Q (ARENA + 60 * MIB)
#define L2_KP (ARENA + 80 * MIB)
#define L2_G (ARENA + 100 * MIB)
#define L2_VTP (ARENA + 120 * MIB)
#define L2_VTS (ARENA + 136 * MIB)
#define L2_KALL (ARENA + 144 * MIB)
#define L2_S1P (ARENA + 152 * MIB)
#define L2_S2P (ARENA + 216 * MIB)
#define L2_S1S (ARENA + 280 * MIB)
#define L2_S2S (ARENA + 360 * MIB)
#define L3_SP (ARENA + 152 * MIB)
#define L3_SS (ARENA + 280 * MIB)

#define OUT_STATE_RET 10485760l
#define OUT_STATE_RWKV 44040192l
#define OUT_DIFF_K 48234496l
#define OUT_DIFF_V 56623104l
#define OUT_NA_K 65011712l
#define OUT_NA_V 73400320l

struct Params {
  const float* in[38];
  float* out;
  char* ws;
};

__device__ __forceinline__ bf16_t f2bf(float f) {
  _Float16 h = (_Float16)f;
  return __builtin_bit_cast(unsigned short, h);
}
__device__ __forceinline__ float bf2f(unsigned h) { return (float)__builtin_bit_cast(_Float16, (unsigned short)h); }
__device__ __forceinline__ unsigned pack2(float a, float b) { return (unsigned)f2bf(a) | ((unsigned)f2bf(b) << 16); }
#define DPPF(x, ctrl) __builtin_bit_cast(float, __builtin_amdgcn_mov_dpp(__builtin_bit_cast(int, (x)), (ctrl), 0xF, 0xF, true))
#define RDLANE(x, l) __builtin_bit_cast(float, __builtin_amdgcn_readlane(__builtin_bit_cast(int, (x)), (l)))
__device__ __forceinline__ float wave_sum(float v) {
  v += DPPF(v, 0xB1);
  v += DPPF(v, 0x4E);
  v += DPPF(v, 0x141);
  v += DPPF(v, 0x140);
  return (RDLANE(v, 0) + RDLANE(v, 16)) + (RDLANE(v, 32) + RDLANE(v, 48));
}
__device__ __forceinline__ float wave_max(float v) {
  v = fmaxf(v, DPPF(v, 0xB1));
  v = fmaxf(v, DPPF(v, 0x4E));
  v = fmaxf(v, DPPF(v, 0x141));
  v = fmaxf(v, DPPF(v, 0x140));
  return fmaxf(fmaxf(RDLANE(v, 0), RDLANE(v, 16)), fmaxf(RDLANE(v, 32), RDLANE(v, 48)));
}
__device__ __forceinline__ void nt_store4(float* ptr, float a, float b, float c, float d) {
  f32x4 v = {a, b, c, d};
  __builtin_nontemporal_store(v, (f32x4*)ptr);
}
__device__ __forceinline__ float silu_f(float x) { return x * __builtin_amdgcn_rcpf(1.f + __expf(-x)); }
__device__ __forceinline__ int perm_ret(int c) {
  int half = c >> 7, r = c & 127;
  return half * 128 + (r & 1) * 64 + (r >> 1);
}
__device__ __forceinline__ int perm_diff(int c) {
  int rr = c & 31;
  return (c & ~31) + (rr & 1) * 16 + (rr >> 1);
}

enum { EPI_F32 = 0, EPI_RET_IN, EPI_RET_S, EPI_OUT, EPI_BF16, EPI_LUP_W, EPI_LUP_A, EPI_DIFF_IN, EPI_NA_IN, EPI_NA_PV };

struct GemmDesc {
  const bf16_t* A; const bf16_t* B;
  long lda, ldb;
  int M, N, K;
  int nb1, nb2;
  long sA1, sA2, sB1, sB2;
  int epi, bn64, flag, layer;
  float* C; long ldc, sC1, sC2; float scale;
  const float* aux;
};

__device__ __forceinline__ void epilogue(const Params& p, const GemmDesc& g, int b1, int b2, int m, int n, f32x4 v) {
  char* ws = p.ws;
  switch (g.epi) {
    case EPI_F32: {
      int mm = m;
      if (g.flag & 1) mm = perm_ret(m);
      float4 o = make_float4(v[0] * g.scale, v[1] * g.scale, v[2] * g.scale, v[3] * g.scale);
      if (g.flag & 2) *(uint2*)((bf16_t*)g.C + b1 * g.sC1 + b2 * g.sC2 + (long)mm * g.ldc + n) = make_uint2(pack2(o.x, o.y), pack2(o.z, o.w));
      else if (g.flag & 1) nt_store4(g.C + b1 * g.sC1 + b2 * g.sC2 + (long)mm * g.ldc + n, o.x, o.y, o.z, o.w);
      else *(float4*)(g.C + b1 * g.sC1 + b2 * g.sC2 + (long)mm * g.ldc + n) = o;
    } break;
    case EPI_BF16: {
      float a0 = v[0], a1 = v[1], a2 = v[2], a3 = v[3];
      if (g.flag & 1) {
        a0 = 1.f - 2.f * __builtin_amdgcn_rcpf(__expf(2.f * a0) + 1.f); a1 = 1.f - 2.f * __builtin_amdgcn_rcpf(__expf(2.f * a1) + 1.f);
        a2 = 1.f - 2.f * __builtin_amdgcn_rcpf(__expf(2.f * a2) + 1.f); a3 = 1.f - 2.f * __builtin_amdgcn_rcpf(__expf(2.f * a3) + 1.f);
      }
      uint2 o = make_uint2(pack2(a0, a1), pack2(a2, a3));
      *(uint2*)((bf16_t*)g.C + (long)m * g.ldc + n) = o;
    } break;
    case EPI_OUT: {
      int cond = (m < TP_) ? 0 : 1 + ((m - TP_) >> 10);
      const float* gate = (const float*)(ws + OFF_MOD) + ((long)g.layer * 3 + cond) * 3072 + 2048 + n;
      const float* res;
      if (g.layer == 0) res = (m < TP_) ? p.in[0] + (long)m * 1024 + n : p.in[1] + (long)(m - TP_) * 1024 + n;
      else res = p.out + (long)m * 1024 + n;
      float4 r = *(const float4*)res;
      float4 gt = *(const float4*)gate;
      float4 o = make_float4(r.x + gt.x * v[0], r.y + gt.y * v[1], r.z + gt.z * v[2], r.w + gt.w * v[3]);
      *(float4*)(p.out + (long)m * 1024 + n) = o;
    } break;
    case EPI_LUP_W: {
      const float4 w4 = *(const float4*)(g.aux + n);
      const float w0[4] = {w4.x, w4.y, w4.z, w4.w};
      float o[4];
#pragma unroll
      for (int j = 0; j < 4; ++j) o[j] = 0.6065306597126334f * __builtin_amdgcn_rcpf(1.f + __expf(-(w0[j] + v[j])));
      *(uint2*)((bf16_t*)g.C + (long)m * 1024 + n) = make_uint2(pack2(o[0], o[1]), pack2(o[2], o[3]));
    } break;
    case EPI_LUP_A: {
      const float4 a4 = *(const float4*)(g.aux + n);
      const float a0[4] = {a4.x, a4.y, a4.z, a4.w};
      float o[4];
#pragma unroll
      for (int j = 0; j < 4; ++j) o[j] = __builtin_amdgcn_rcpf(1.f + __expf(-(a0[j] + v[j])));
      *(uint2*)((bf16_t*)g.C + (long)m * 1024 + n) = make_uint2(pack2(o[0], o[1]), pack2(o[2], o[3]));
    } break;
    case EPI_RET_IN: {
      const bool sample = m >= TP_;
      const int sb = (m - TP_) >> 10, ls = (m - TP_) & 1023;
      const int pb = m >> 8, lp = m & 255;
      const float* lg = (const float*)(ws + OFF_TAB);
      if (n < 2048) {
        const bool isk = n >= 1024;
        const int c = n & 1023, h = c >> 8, dk = c & 255;
        float x[4] = {v[0], v[1], v[2], v[3]};
        if (isk) { x[0] *= 0.0625f; x[1] *= 0.0625f; x[2] *= 0.0625f; x[3] *= 0.0625f; }
        if (sample) {
          const int half = dk >> 7;
          const float pos = half ? (float)(ls & 63) : (float)(ls >> 6);
#pragma unroll
          for (int pp = 0; pp < 2; ++pp) {
            int i = ((dk & 127) >> 1) + pp;
            float inv = __builtin_amdgcn_exp2f(-(float)i * (13.287712379549449f / 64.f));
            float ang = pos * inv;
            float cs = __cosf(ang), sn = __sinf(ang);
            float x1 = x[2 * pp], x2 = x[2 * pp + 1];
            x[2 * pp] = x1 * cs - x2 * sn;
            x[2 * pp + 1] = x1 * sn + x2 * cs;
          }
        }
        bf16_t* dst = (bf16_t*)(ws + (isk ? L0_K : L0_Q)) + (long)m * 1024 + c;
        *(uint2*)dst = make_uint2(pack2(x[0], x[1]), pack2(x[2], x[3]));
        if (sample && !isk) {
          float df = __expf(lg[h] * (float)(ls + 1));
          float db = __expf(lg[4 + h] * (float)(1024 - ls));
          bf16_t* pe = (bf16_t*)(ws + L0_PEXT) + ((long)(sb * 4 + h) * 1024 + ls) * 1536 + 1024 + dk;
          *(uint2*)pe = make_uint2(pack2(x[0] * df, x[1] * df), pack2(x[2] * df, x[3] * df));
          *(uint2*)(pe + 256) = make_uint2(pack2(x[0] * db, x[1] * db), pack2(x[2] * db, x[3] * db));
        }
        if (!sample && isk) {
          float df = __expf(lg[h] * (float)(255 - lp));
          float db = __expf(lg[4 + h] * (float)lp);
          bf16_t* kt0 = (bf16_t*)(ws + L0_KT) + ((long)((0 * 32 + pb) * 4 + h) * 256 + dk) * 256 + lp;
          bf16_t* kt1 = (bf16_t*)(ws + L0_KT) + ((long)((1 * 32 + pb) * 4 + h) * 256 + dk) * 256 + lp;
#pragma unroll
          for (int j = 0; j < 4; ++j) { kt0[j * 256] = f2bf(x[j] * df); kt1[j * 256] = f2bf(x[j] * db); }
        }
      } else if (n < 4096) {
        const int c = n - 2048, h = c >> 9, dv = c & 511;
        if (sample) {
          bf16_t* vt = (bf16_t*)(ws + L0_VTS) + ((long)(sb * 4 + h) * 512 + dv) * 1536 + ls;
#pragma unroll
          for (int j = 0; j < 4; ++j) vt[j * 1536] = f2bf(v[j]);
        } else {
          bf16_t* vt = (bf16_t*)(ws + L0_VTP) + ((long)(pb * 4 + h) * 512 + dv) * 256 + lp;
#pragma unroll
          for (int j = 0; j < 4; ++j) vt[j * 256] = f2bf(v[j]);
        }
      } else {
        bf16_t* dst = (bf16_t*)(ws + L0_G) + (long)m * 2048 + (n - 4096);
        *(uint2*)dst = make_uint2(pack2(v[0], v[1]), pack2(v[2], v[3]));
      }
    } break;
    case EPI_RET_S: {
      const float* lg = (const float*)(ws + OFF_TAB);
      const float lgf = lg[b2], lgb = lg[4 + b2];
      float o[4];
#pragma unroll
      for (int j = 0; j < 4; ++j) {
        int d = m - (n + j);
        float arg = (d > 0) ? lgf * (float)d : lgb * (float)(-d);
        float f = (d == 0) ? 2.f : __expf(arg);
        o[j] = v[j] * f;
      }
      bf16_t* dst = (bf16_t*)g.C + b1 * g.sC1 + b2 * g.sC2 + (long)m * g.ldc + n;
      *(uint2*)dst = make_uint2(pack2(o[0], o[1]), pack2(o[2], o[3]));
    } break;
    case EPI_DIFF_IN: {
      const bool sample = m >= TP_;
      const int sb = (m - TP_) >> 10, ls = (m - TP_) & 1023;
      const int pb = m >> 8, lp = m & 255;
      if (n < 2048) {
        const bool isk = n >= 1024;
        const int c = n & 1023, h = c >> 7, d = c & 127;
        float x[4] = {v[0], v[1], v[2], v[3]};
        if (sample) {
          const int half = (d >> 5) & 1;
          const float pos = half ? (float)(ls & 63) : (float)(ls >> 6);
#pragma unroll
          for (int pp = 0; pp < 2; ++pp) {
            int i = ((d & 31) >> 1) + pp;
            float inv = __builtin_amdgcn_exp2f(-(float)i * (13.287712379549449f / 16.f));
            float ang = pos * inv;
            float cs = __cosf(ang), sn = __sinf(ang);
            float x1 = x[2 * pp], x2 = x[2 * pp + 1];
            x[2 * pp] = x1 * cs - x2 * sn;
            x[2 * pp + 1] = x1 * sn + x2 * cs;
          }
        }
        uint2 pk = make_uint2(pack2(x[0], x[1]), pack2(x[2], x[3]));
        if (!isk) {
          *(uint2*)((bf16_t*)(ws + L2_Q) + (long)m * 1024 + c) = pk;
        } else if (sample) {
          *(uint2*)((bf16_t*)(ws + L2_KALL) + ((long)(sb * 8 + h) * 1280 + ls) * 128 + d) = pk;
        } else {
          *(uint2*)((bf16_t*)(ws + L2_KP) + (long)m * 1024 + c) = pk;
          float* ck = p.out + OUT_DIFF_K + ((long)(pb * 8 + h) * 256 + lp) * 128 + (d & ~31) + ((d & 31) >> 1);
          *(float2*)ck = make_float2(v[0], v[2]);
          *(float2*)(ck + 16) = make_float2(v[1], v[3]);
        }
      } else if (n < 3072) {
        const int c = n - 2048, h = c >> 7, dv = c & 127;
        if (sample) {
          bf16_t* vt = (bf16_t*)(ws + L2_VTS) + ((long)(sb * 8 + h) * 128 + dv) * 1280 + ls;
#pragma unroll
          for (int j = 0; j < 4; ++j) vt[j * 1280] = f2bf(v[j]);
        } else {
          bf16_t* vt = (bf16_t*)(ws + L2_VTP) + ((long)(pb * 8 + h) * 128 + dv) * 256 + lp;
#pragma unroll
          for (int j = 0; j < 4; ++j) vt[j * 256] = f2bf(v[j]);
          nt_store4(p.out + OUT_DIFF_V + ((long)(pb * 8 + h) * 256 + lp) * 128 + dv, v[0], v[1], v[2], v[3]);
        }
      } else {
        *(uint2*)((bf16_t*)(ws + L2_G) + (long)m * 1024 + (n - 3072)) = make_uint2(pack2(v[0], v[1]), pack2(v[2], v[3]));
      }
    } break;
    case EPI_NA_IN: {
      const bool sample = m >= TP_;
      const int sb = (m - TP_) >> 10, ls = (m - TP_) & 1023;
      const int pb = m >> 8, lp = m & 255;
      uint2 pk = make_uint2(pack2(v[0], v[1]), pack2(v[2], v[3]));
      if (n < 1024) {
        *(uint2*)((bf16_t*)(ws + L2_Q) + (long)m * 1024 + n) = pk;
      } else if (n < 2048) {
        const int c = n - 1024, h = c >> 6, d = c & 63;
        if (sample) {
          *(uint2*)((bf16_t*)(ws + L2_KALL) + ((long)(sb * 16 + h) * 1280 + ls) * 64 + d) = pk;
        } else {
          *(uint2*)((bf16_t*)(ws + L2_KP) + (long)m * 1024 + c) = pk;
          nt_store4(p.out + OUT_NA_K + ((long)(pb * 16 + h) * 256 + lp) * 64 + d, v[0], v[1], v[2], v[3]);
        }
      } else if (n < 3072) {
        const int c = n - 2048, h = c >> 6, dv = c & 63;
        if (sample) {
          bf16_t* vt = (bf16_t*)(ws + L2_VTS) + ((long)(sb * 16 + h) * 64 + dv) * 1280 + ls;
#pragma unroll
          for (int j = 0; j < 4; ++j) vt[j * 1280] = f2bf(v[j]);
        } else {
          bf16_t* vt = (bf16_t*)(ws + L2_VTP) + ((long)(pb * 16 + h) * 64 + dv) * 256 + lp;
#pragma unroll
          for (int j = 0; j < 4; ++j) vt[j * 256] = f2bf(v[j]);
          nt_store4(p.out + OUT_NA_V + ((long)(pb * 16 + h) * 256 + lp) * 64 + dv, v[0], v[1], v[2], v[3]);
        }
      } else {
        *(uint2*)((bf16_t*)(ws + L2_G) + (long)m * 1024 + (n - 3072)) = pk;
      }
    } break;
  }
}

#define LDS_STRIDE 64
typedef __attribute__((address_space(3))) unsigned lds_u32;
template <int NT, int MI>
__device__ __forceinline__ void gemm_tile(const Params& p, const GemmDesc& g, int b1, int b2, int m0, int n0, char* smem) {
  constexpr int BN = NT * 32;
  constexpr int BM = MI * 32;
  bf16_t* As = (bf16_t*)smem;
  bf16_t* Bs = As + 2 * BM * LDS_STRIDE;
  const int tid = threadIdx.x, lane = tid & 63, wave = tid >> 6, wr = wave >> 1, wc = wave & 1, l15 = lane & 15, q4 = lane >> 4;
  const bf16_t* Ab = g.A + b1 * g.sA1 + b2 * g.sA2 + (long)m0 * g.lda;
  const bf16_t* Bb = g.B + b1 * g.sB1 + b2 * g.sB2 + (long)n0 * g.ldb;
  f32x4 acc[MI][NT];
#pragma unroll
  for (int i = 0; i < MI; ++i)
#pragma unroll
    for (int j = 0; j < NT; ++j) acc[i][j] = (f32x4){0.f, 0.f, 0.f, 0.f};
  const int nk = g.K >> 6;
  const int rsw = (l15 >> 1) & 7;
  const int prow = lane >> 3;
  const int gch = (lane & 7) ^ (((wave & 1) << 2) | (prow >> 1));
  const bf16_t* Ag = Ab + (long)(wave * 8 + prow) * g.lda + gch * 8;
  const bf16_t* Bg = Bb + (long)(wave * 8 + prow) * g.ldb + gch * 8;
  const long a32 = 32 * g.lda, b32 = 32 * g.ldb;
#define DMA(kt, buf)                                                                                         \
  {                                                                                                          \
    _Pragma("unroll") for (int i = 0; i < MI; ++i)                                                           \
      __builtin_amdgcn_global_load_lds((const unsigned*)(Ag + i * a32 + (kt) * 64),                          \
          (lds_u32*)((char*)As + (buf) * (BM * 128) + (i * 4 + wave) * 1024 + lane * 16), 16, 0, 0);         \
    _Pragma("unroll") for (int i = 0; i < NT / 1; ++i) if (i < BN / 32)                                      \
      __builtin_amdgcn_global_load_lds((const unsigned*)(Bg + i * b32 + (kt) * 64),                          \
          (lds_u32*)((char*)Bs + (buf) * (BN * 128) + (i * 4 + wave) * 1024 + lane * 16), 16, 0, 0);         \
  }
  bf16x8 af[2][MI], bfr[2][NT];
#define LOADFRAGS(buf)                                                                     \
  _Pragma("unroll") for (int ks = 0; ks < 2; ++ks) {                                       \
    _Pragma("unroll") for (int mi = 0; mi < MI; ++mi)                                      \
      af[ks][mi] = *(const bf16x8*)(As + ((buf) * BM + wr * (MI * 16) + mi * 16 + l15) * LDS_STRIDE + (((ks * 4 + q4) ^ rsw) << 3)); \
    _Pragma("unroll") for (int ni = 0; ni < NT; ++ni)                                      \
      bfr[ks][ni] = *(const bf16x8*)(Bs + ((buf) * BN + wc * (NT * 16) + ni * 16 + l15) * LDS_STRIDE + (((ks * 4 + q4) ^ rsw) << 3)); \
  }
#define COMPUTE()                                                                          \
  _Pragma("unroll") for (int ks = 0; ks < 2; ++ks)                                         \
    _Pragma("unroll") for (int mi = 0; mi < MI; ++mi)                                      \
      _Pragma("unroll") for (int ni = 0; ni < NT; ++ni)                                    \
        acc[mi][ni] = __builtin_amdgcn_mfma_f32_16x16x32_f16(bfr[ks][ni], af[ks][mi], acc[mi][ni], 0, 0, 0);
  DMA(0, 0)
  asm volatile("s_waitcnt vmcnt(0)" ::: "memory");
  __syncthreads();
  for (int kt = 0; kt < nk; ++kt) {
    const int buf = kt & 1;
    LOADFRAGS(buf)
    __builtin_amdgcn_sched_barrier(0);
    if (kt + 1 < nk) DMA(kt + 1, buf ^ 1)
    __builtin_amdgcn_sched_barrier(0);
    COMPUTE()
    __builtin_amdgcn_sched_barrier(0);
    asm volatile("s_waitcnt vmcnt(0)" ::: "memory");
    __syncthreads();
  }
#undef LOADFRAGS
#undef COMPUTE
#undef DMA
#pragma unroll
  for (int mi = 0; mi < MI; ++mi)
#pragma unroll
    for (int ni = 0; ni < NT; ++ni) {
      int m = m0 + wr * (MI * 16) + mi * 16 + l15;
      int n = n0 + wc * (NT * 16) + ni * 16 + q4 * 4;
      epilogue(p, g, b1, b2, m, n, acc[mi][ni]);
    }
}

__device__ __forceinline__ int desc_tiles(const GemmDesc& g) {
  int bn = g.bn64 ? 64 : 128;
  int bm = (g.flag & 256) ? 160 : 128;
  return g.nb1 * g.nb2 * (g.M / bm) * (g.N / bn);
}
__device__ __forceinline__ void run_desc_tile(const Params& p, const GemmDesc& g, int tile, char* smem) {
  int bn = g.bn64 ? 64 : 128;
  int bm = (g.flag & 256) ? 160 : 128;
  int tm = g.M / bm, tn = g.N / bn;
  int per = tm * tn;
  int batch = tile / per, rem = tile - batch * per;
  int nt = rem / tm, mt = rem - nt * tm;
  if (false && g.nb1 * g.nb2 == 1 && (tm & 7) == 0) {
    int snw = tn < 8 ? tn : 8;
    int sz = 8 * snw;
    int sup = rem / sz, within = rem - sup * sz;
    int nsm = tm >> 3;
    int sn = sup / nsm, sm_ = sup - sn * nsm;
    mt = sm_ * 8 + (within & 7);
    nt = sn * snw + (within >> 3);
  }
  int b1 = batch / g.nb2, b2 = batch - b1 * g.nb2;
  if (g.flag & 256) gemm_tile<4, 5>(p, g, b1, b2, mt * 160, nt * 128, smem);
  else if (g.bn64) gemm_tile<2, 4>(p, g, b1, b2, mt * 128, nt * 64, smem);
  else gemm_tile<4, 4>(p, g, b1, b2, mt * 128, nt * 128, smem);
}

__device__ __forceinline__ GemmDesc mkdesc(const void* A, long lda, const void* B, long ldb, int M, int N, int K, int epi) {
  GemmDesc g;
  g.A = (const bf16_t*)A; g.B = (const bf16_t*)B;
  g.lda = lda; g.ldb = ldb; g.M = M; g.N = N; g.K = K; g.nb1 = 1; g.nb2 = 1;
  g.sA1 = g.sA2 = g.sB1 = g.sB2 = 0; g.epi = epi; g.bn64 = 0; g.flag = 0; g.layer = 0;
  g.C = nullptr; g.ldc = 0; g.sC1 = g.sC2 = 0; g.scale = 1.f; g.aux = nullptr;
  return g;
}

__device__ __forceinline__ int get_descs(const Params& p, int gp, int idx, GemmDesc& g) {
  char* ws = p.ws;
  switch (gp) {
    case 0:
      g = mkdesc(ws + OFF_H, 1024, ws + OFF_WT_RET_IN, 1024, T_, 6144, 1024, EPI_RET_IN); g.flag = 256;
      return 1;
    case 1:
      if (idx == 0) {
        g = mkdesc(ws + L0_Q, 1024, ws + L0_K, 1024, 256, 256, 256, EPI_RET_S);
        g.nb1 = 32; g.nb2 = 4; g.sA1 = 256 * 1024; g.sA2 = 256; g.sB1 = 256 * 1024; g.sB2 = 256;
        g.C = (float*)(ws + L0_SP); g.ldc = 256; g.sC1 = 4 * 65536; g.sC2 = 65536;
      } else if (idx == 1) {
        g = mkdesc((bf16_t*)(ws + L0_Q) + (long)TP_ * 1024, 1024, (bf16_t*)(ws + L0_K) + (long)TP_ * 1024, 1024, 1024, 1024, 256, EPI_RET_S);
        g.nb1 = 2; g.nb2 = 4; g.sA1 = 1024 * 1024; g.sA2 = 256; g.sB1 = 1024 * 1024; g.sB2 = 256;
        g.C = (float*)(ws + L0_PEXT); g.ldc = 1536; g.sC1 = 4l * 1024 * 1536; g.sC2 = 1024l * 1536;
      } else {
        int dir = idx - 2;
        g = mkdesc((bf16_t*)(ws + L0_KT) + (long)dir * 32 * 4 * 65536, 256, ws + L0_VTP, 256, 256, 512, 256, EPI_F32);
        g.nb1 = 32; g.nb2 = 4; g.sA1 = 4 * 65536; g.sA2 = 65536; g.sB1 = 4 * 131072; g.sB2 = 131072;
        g.C = p.out + OUT_STATE_RET + (long)dir * 4 * 131072; g.ldc = 512; g.sC1 = 8 * 131072; g.sC2 = 131072; g.flag = 1;
      }
      return 4;
    case 2:
      if (idx == 1) {
        g = mkdesc(ws + L0_SP, 256, ws + L0_VTP, 256, 256, 512, 256, EPI_F32);
        g.nb1 = 32; g.nb2 = 4; g.sA1 = 4 * 65536; g.sA2 = 65536; g.sB1 = 4 * 131072; g.sB2 = 131072;
        g.C = (float*)(ws + L0_O); g.ldc = 2048; g.sC1 = 256 * 2048; g.sC2 = 512; g.flag = 2;
      } else {
        g = mkdesc(ws + L0_PEXT, 1536, ws + L0_VTS, 1536, 1024, 512, 1536, EPI_F32);
        g.nb1 = 2; g.nb2 = 4; g.sA1 = 4l * 1024 * 1536; g.sA2 = 1024l * 1536; g.sB1 = 4l * 512 * 1536; g.sB2 = 512l * 1536;
        g.C = (float*)((bf16_t*)(ws + L0_O) + (long)TP_ * 2048); g.ldc = 2048; g.sC1 = 1024 * 2048; g.sC2 = 512; g.flag = 2;
      }
      return 2;
    case 3:
      g = mkdesc(ws + OFF_OB, 2048, ws + OFF_WT_RET_OUT, 2048, T_, 1024, 2048, EPI_OUT); g.layer = 0; g.flag = 256;
      return 1;
    case 4: {
      if (idx < 4) {
        g = mkdesc(ws + L1_XM + (long)idx * 20 * MIB, 1024, (bf16_t*)(ws + OFF_WT_RWKV_IN) + (long)idx * 1024 * 1024, 1024, T_, 1024, 1024, EPI_BF16);
        g.C = (float*)((bf16_t*)(ws + L1_RKVG) + idx * 1024); g.ldc = 4096;
      } else {
        int w = idx - 4;
        g = mkdesc(ws + L1_XW + (long)w * 20 * MIB, 1024, (bf16_t*)(ws + OFF_WT_LDOWN) + (long)w * 128 * 1024, 1024, T_, 128, 1024, EPI_BF16);
        g.C = (float*)((bf16_t*)(ws + L1_L) + w * 128); g.ldc = 256; g.flag = (w == 0) ? 1 : 0;
      }
      return 6;
    }
    case 5: {
      int dir = idx >> 1, type = idx & 1;
      g = mkdesc((bf16_t*)(ws + L1_L) + type * 128 + dir * 64, 256, (bf16_t*)(ws + OFF_WT_LUP) + (long)(type * 2 + dir) * 65536, 64, T_, 1024, 64,
                 type ? EPI_LUP_A : EPI_LUP_W);
      g.C = (float*)((bf16_t*)(ws + (type ? L1_AA : L1_DEC)) + (long)dir * T_ * 1024);
      g.aux = (type ? p.in[23] : p.in[20]) + dir * 1024;
      return 4;
    }
    case 6:
      g = mkdesc(ws + OFF_OB, 1024, ws + OFF_WT_RWKV_OUT, 1024, T_, 1024, 1024, EPI_OUT); g.layer = 1; g.flag = 256;
      return 1;
    case 7:
      g = mkdesc(ws + OFF_H, 1024, ws + OFF_WT_DIFF_IN, 1024, T_, 4096, 1024, EPI_DIFF_IN); g.flag = 256;
      return 1;
    case 10:
      g = mkdesc(ws + OFF_OB, 1024, ws + OFF_WT_DIFF_OUT, 1024, T_, 1024, 1024, EPI_OUT); g.layer = 2; g.flag = 256;
      return 1;
    case 11:
      g = mkdesc(ws + OFF_H, 1024, ws + OFF_WT_NA_IN, 1024, T_, 4096, 1024, EPI_NA_IN); g.flag = 256;
      return 1;
    case 14:
      g = mkdesc(ws + OFF_OB, 1024, ws + OFF_WT_NA_OUT, 1024, T_, 1024, 1024, EPI_OUT); g.layer = 3; g.flag = 256;
      return 1;
  }
  return 0;
}

__device__ __forceinline__ void gemm_phase(const Params& p, int gp, char* smem, int vb) {
  GemmDesc g;
  int nd = get_descs(p, gp, 0, g);
  int base = 0;
  int tile = vb;
  for (int d = 0; d < nd; ++d) {
    if (d > 0) get_descs(p, gp, d, g);
    int nt = desc_tiles(g);
    while (tile < base + nt) {
      run_desc_tile(p, g, tile - base, smem);
      tile += gridDim.x;
    }
    base += nt;
  }
}

struct TJob { const float* src; int K, N; bf16_t* dst; int perm; };
__device__ __forceinline__ TJob tjob(const Params& p, int j) {
  char* ws = p.ws;
  TJob t; t.perm = 0;
  switch (j) {
    case 0: t.src = p.in[14]; t.K = 1024; t.N = 6144; t.dst = (bf16_t*)(ws + OFF_WT_RET_IN); t.perm = 1; break;
    case 1: t.src = p.in[17]; t.K = 2048; t.N = 1024; t.dst = (bf16_t*)(ws + OFF_WT_RET_OUT); break;
    case 2: t.src = p.in[19]; t.K = 1024; t.N = 4096; t.dst = (bf16_t*)(ws + OFF_WT_RWKV_IN); break;
    case 3: t.src = p.in[30]; t.K = 1024; t.N = 1024; t.dst = (bf16_t*)(ws + OFF_WT_RWKV_OUT); break;
    case 4: t.src = p.in[31]; t.K = 1024; t.N = 4096; t.dst = (bf16_t*)(ws + OFF_WT_DIFF_IN); t.perm = 2; break;
    case 5: t.src = p.in[34]; t.K = 1024; t.N = 1024; t.dst = (bf16_t*)(ws + OFF_WT_DIFF_OUT); break;
    case 6: t.src = p.in[35]; t.K = 1024; t.N = 4096; t.dst = (bf16_t*)(ws + OFF_WT_NA_IN); break;
    case 7: t.src = p.in[37]; t.K = 1024; t.N = 1024; t.dst = (bf16_t*)(ws + OFF_WT_NA_OUT); break;
    case 8: case 9: t.src = p.in[21] + (j - 8) * 65536; t.K = 1024; t.N = 64; t.dst = (bf16_t*)(ws + OFF_WT_LDOWN) + (long)(j - 8) * 64 * 1024; break;
    case 10: case 11: t.src = p.in[24] + (j - 10) * 65536; t.K = 1024; t.N = 64; t.dst = (bf16_t*)(ws + OFF_WT_LDOWN) + (long)(128 + (j - 10) * 64) * 1024; break;
    case 12: case 13: t.src = p.in[22] + (j - 12) * 65536; t.K = 64; t.N = 1024; t.dst = (bf16_t*)(ws + OFF_WT_LUP) + (long)(j - 12) * 65536; break;
    default: t.src = p.in[25] + (j - 14) * 65536; t.K = 64; t.N = 1024; t.dst = (bf16_t*)(ws + OFF_WT_LUP) + (long)(2 + j - 14) * 65536; break;
  }
  return t;
}

__device__ __forceinline__ void transpose_tile(const TJob& t, int tile, char* smem) {
  float* sm = (float*)smem;
  const int tid = threadIdx.x;
  int tn = t.N >> 6;
  int kt = tile / tn, nt = tile - kt * tn;
  int k0 = kt * 64, n0 = nt * 64;
  __syncthreads();
#pragma unroll
  for (int it = 0; it < 16; ++it) {
    int kk = it * 4 + (tid >> 6), nn = tid & 63;
    int nd = n0 + nn;
    int ns = nd;
    if (t.perm == 1 && nd < 2048) ns = (nd & ~255) + perm_ret(nd & 255);
    else if (t.perm == 2 && nd < 2048) ns = perm_diff(nd);
    sm[kk * 65 + nn] = t.src[(long)(k0 + kk) * t.N + ns];
  }
  __syncthreads();
#pragma unroll
  for (int it = 0; it < 2; ++it) {
    int gidx = tid + it * 256;
    int n = gidx >> 3, kg = gidx & 7;
    unsigned w[4];
#pragma unroll
    for (int e = 0; e < 4; ++e) w[e] = pack2(sm[(kg * 8 + 2 * e) * 65 + n], sm[(kg * 8 + 2 * e + 1) * 65 + n]);
    *(uint4*)(t.dst + (long)(n0 + n) * t.K + k0 + kg * 8) = make_uint4(w[0], w[1], w[2], w[3]);
  }
}

__device__ __forceinline__ void transposes_subset(const Params& p, char* smem, unsigned mask, int worker, int nworkers) {
  int base = 0, tile = worker;
  for (int j = 0; j < 16; ++j) {
    if (!((mask >> j) & 1u)) continue;
    TJob t = tjob(p, j);
    int nt = (t.K >> 6) * (t.N >> 6);
    while (tile < base + nt) { transpose_tile(t, tile - base, smem); tile += nworkers; }
    base += nt;
  }
  __syncthreads();
}
__device__ __forceinline__ void mod_gemv_items(const Params& p, char* smem, int item_lo, int item_hi, int worker, int nworkers) {
  char* ws = p.ws;
  const int tid = threadIdx.x;

    float* sm = (float*)smem;
    const float* wmod = p.in[11];
    const float* bmod = p.in[12];
    for (int item = item_lo + worker; item < item_hi; item += nworkers) {
      int layer = item / 192, cg16 = item - layer * 192;
      int j0 = cg16 * 16;
      int c4 = tid & 3, r = tid >> 2;
      float acc[3][4];
#pragma unroll
      for (int c = 0; c < 3; ++c)
#pragma unroll
        for (int e = 0; e < 4; ++e) acc[c][e] = 0.f;
      float4 wr[16];
#pragma unroll
      for (int it = 0; it < 16; ++it)
        wr[it] = *(const float4*)(wmod + ((long)layer * 1024 + r + it * 64) * 3072 + j0 + c4 * 4);
#pragma unroll
      for (int it = 0; it < 16; ++it) {
        int row = r + it * 64;
        float4 w = wr[it];
        float cv0 = p.in[9][row], cv1 = p.in[8][row], cv2 = p.in[8][1024 + row];
        float s0 = silu_f(cv0), s1 = silu_f(cv1), s2 = silu_f(cv2);
        acc[0][0] += s0 * w.x; acc[0][1] += s0 * w.y; acc[0][2] += s0 * w.z; acc[0][3] += s0 * w.w;
        acc[1][0] += s1 * w.x; acc[1][1] += s1 * w.y; acc[1][2] += s1 * w.z; acc[1][3] += s1 * w.w;
        acc[2][0] += s2 * w.x; acc[2][1] += s2 * w.y; acc[2][2] += s2 * w.z; acc[2][3] += s2 * w.w;
      }
      __syncthreads();
#pragma unroll
      for (int c = 0; c < 3; ++c)
#pragma unroll
        for (int e = 0; e < 4; ++e) sm[tid * 12 + c * 4 + e] = acc[c][e];
      __syncthreads();
      if (tid < 48) {
        int c = tid / 16, col = tid & 15;
        int cc4 = col >> 2, e = col & 3;
        float s = 0.f;
        for (int rr = 0; rr < 64; ++rr) s += sm[(rr * 4 + cc4) * 12 + c * 4 + e];
        ((float*)(ws + OFF_MOD))[((long)layer * 3 + c) * 3072 + j0 + col] = s + bmod[layer * 3072 + j0 + col];
      }
    }
    __syncthreads();
}

__device__ __forceinline__ void prep_phase(const Params& p, char* smem) {
  char* ws = p.ws;
  const int tid = threadIdx.x;
  transposes_subset(p, smem, (gridDim.x == 512) ? 0x0001u : 0xFFFFu, blockIdx.x, gridDim.x);
  __syncthreads();
  mod_gemv_items(p, smem, 0, (gridDim.x == 512) ? 192 : 768, blockIdx.x, gridDim.x);
  const long gtid = (long)blockIdx.x * 256 + tid;
  const long gn = (long)gridDim.x * 256;
  if (gtid < 8) {
    float x = p.in[15][gtid];
    float u = -x;
    ((float*)(ws + OFF_TAB))[gtid] = -(fmaxf(u, 0.f) + log1pf(expf(-fabsf(u))));
  }
  for (long i = gtid; i < 2l * 4 * 512 * 512; i += gn) {
    int col = i & 511; long r = i >> 9; int dv = r & 511; r >>= 9; int h = r & 3; int sb = r >> 2;
    int dir = col >> 8, dkp = col & 255;
    float v = p.in[2][((((long)sb * 2 + dir) * 4 + h) * 256 + perm_ret(dkp)) * 512 + dv];
    ((bf16_t*)(ws + L0_VTS))[((long)(sb * 4 + h) * 512 + dv) * 1536 + 1024 + col] = f2bf(v);
  }
}

__device__ __forceinline__ void diff_cache_prep(const Params& p) {
  char* ws = p.ws;
  const long gtid = (long)blockIdx.x * 256 + threadIdx.x;
  const long gn = (long)gridDim.x * 256;
  for (long i = gtid; i < 2l * 8 * 256 * 128; i += gn) {
    int d = i & 127; long r = i >> 7; int pp = r & 255; r >>= 8; int h = r & 7; int sb = r >> 3;
    float kv = p.in[4][((long)(sb * 8 + h) * 256 + pp) * 128 + perm_diff(d)];
    ((bf16_t*)(ws + L2_KALL))[((long)(sb * 8 + h) * 1280 + 1024 + pp) * 128 + d] = f2bf(kv);
  }
  for (long i = gtid; i < 2l * 8 * 128 * 256; i += gn) {
    int pp = i & 255; long r = i >> 8; int dv = r & 127; r >>= 7; int h = r & 7; int sb = r >> 3;
    float vv = p.in[5][((long)(sb * 8 + h) * 256 + pp) * 128 + dv];
    ((bf16_t*)(ws + L2_VTS))[((long)(sb * 8 + h) * 128 + dv) * 1280 + 1024 + pp] = f2bf(vv);
  }
}

__device__ __forceinline__ void na_cache_prep(const Params& p) {
  char* ws = p.ws;
  const long gtid = (long)blockIdx.x * 256 + threadIdx.x;
  const long gn = (long)gridDim.x * 256;
  for (long i = gtid; i < 2l * 16 * 256 * 64; i += gn) {
    int d = i & 63; long r = i >> 6; int pp = r & 255; r >>= 8; int h = r & 15; int sb = r >> 4;
    float kv = p.in[6][((long)(sb * 16 + h) * 256 + pp) * 64 + d];
    ((bf16_t*)(ws + L2_KALL))[((long)(sb * 16 + h) * 1280 + 1024 + pp) * 64 + d] = f2bf(kv);
  }
  for (long i = gtid; i < 2l * 16 * 64 * 256; i += gn) {
    int pp = i & 255; long r = i >> 8; int dv = r & 63; r >>= 6; int h = r & 15; int sb = r >> 4;
    float vv = p.in[7][((long)(sb * 16 + h) * 256 + pp) * 64 + dv];
    ((bf16_t*)(ws + L2_VTS))[((long)(sb * 16 + h) * 64 + dv) * 1280 + 1024 + pp] = f2bf(vv);
  }
}

__device__ __forceinline__ const float* xrow(const Params& p, int layer, int t) {
  if (layer == 0) return (t < TP_) ? p.in[0] + (long)t * 1024 : p.in[1] + (long)(t - TP_) * 1024;
  return p.out + (long)t * 1024;
}
struct F16 { float4 v[4]; };
__device__ __forceinline__ F16 norm_row(const Params& p, int layer, int t, int lane) {
  const float* x = xrow(p, layer, t);
  F16 h;
  float ss = 0.f;
#pragma unroll
  for (int it = 0; it < 4; ++it) {
    float4 v = *(const float4*)(x + it * 256 + lane * 4);
    h.v[it] = v;
    ss += v.x * v.x + v.y * v.y + v.z * v.z + v.w * v.w;
  }
  ss = wave_sum(ss);
  float rinv = rsqrtf(ss * (1.f / 1024.f) + 1e-6f);
  int cond = (t < TP_) ? 0 : 1 + ((t - TP_) >> 10);
  const float* mod = (const float*)(p.ws + OFF_MOD) + ((long)layer * 3 + cond) * 3072;
  const float* nw = p.in[10] + layer * 1024;
#pragma unroll
  for (int it = 0; it < 4; ++it) {
    int c = it * 256 + lane * 4;
    float4 w = *(const float4*)(nw + c);
    float4 sh = *(const float4*)(mod + c);
    float4 sc = *(const float4*)(mod + 1024 + c);
    h.v[it].x = h.v[it].x * rinv * w.x * (1.f + sc.x) + sh.x;
    h.v[it].y = h.v[it].y * rinv * w.y * (1.f + sc.y) + sh.y;
    h.v[it].z = h.v[it].z * rinv * w.z * (1.f + sc.z) + sh.z;
    h.v[it].w = h.v[it].w * rinv * w.w * (1.f + sc.w) + sh.w;
  }
  return h;
}
__device__ __forceinline__ void norm_phase(const Params& p, int layer) {
  const int lane = threadIdx.x & 63;
  const int gw = blockIdx.x * 4 + (threadIdx.x >> 6), nw = gridDim.x * 4;
  bf16_t* H = (bf16_t*)(p.ws + OFF_H);
  if (layer != 1) {
    for (int t = gw; t < T_; t += nw) {
      F16 h = norm_row(p, layer, t, lane);
#pragma unroll
      for (int it = 0; it < 4; ++it)
        *(uint2*)(H + (long)t * 1024 + it * 256 + lane * 4) = make_uint2(pack2(h.v[it].x, h.v[it].y), pack2(h.v[it].z, h.v[it].w));
    }
  } else {
    const float* mu = p.in[18];
    for (int chunk = gw; chunk < T_ / 4; chunk += nw) {
      const int t0 = chunk * 4;
      const int L = (t0 < TP_) ? 256 : 1024;
      const int l0 = (t0 < TP_) ? (t0 & 255) : ((t0 - TP_) & 1023);
      const bool hasp = l0 > 0, hasn = (l0 + 4 < L);
      float rinv[6];
#pragma unroll
      for (int j = 0; j < 6; ++j) {
        const bool ok = (j == 0) ? hasp : ((j == 5) ? hasn : true);
        const float* x = xrow(p, layer, ok ? (t0 - 1 + j) : t0);
        float ss = 0.f;
#pragma unroll
        for (int it = 0; it < 4; ++it) {
          const float4 v = *(const float4*)(x + it * 256 + lane * 4);
          ss += v.x * v.x + v.y * v.y + v.z * v.z + v.w * v.w;
        }
        rinv[j] = ok ? rsqrtf(wave_sum(ss) * (1.f / 1024.f) + 1e-6f) : 0.f;
      }
      const int cond = (t0 < TP_) ? 0 : 1 + ((t0 - TP_) >> 10);
      const float* mod = (const float*)(p.ws + OFF_MOD) + ((long)layer * 3 + cond) * 3072;
      const float* nwp = p.in[10] + layer * 1024;
#pragma unroll
      for (int it = 0; it < 4; ++it) {
        const int c = it * 256 + lane * 4;
        const float4 w = *(const float4*)(nwp + c);
        const float4 sh = *(const float4*)(mod + c);
        const float4 sc = *(const float4*)(mod + 1024 + c);
        const float4 ws4 = make_float4(w.x * (1.f + sc.x), w.y * (1.f + sc.y), w.z * (1.f + sc.z), w.w * (1.f + sc.w));
        float4 hr0, hr1, hr2, hr3, hr4, hr5;
#define NROW(dst, j)                                                                            \
        {                                                                                       \
          const bool ok = ((j) == 0) ? hasp : (((j) == 5) ? hasn : true);                        \
          const float4 v = *(const float4*)(xrow(p, layer, ok ? (t0 - 1 + (j)) : t0) + c);       \
          const float ri = rinv[j];                                                              \
          dst = ok ? make_float4(v.x * ri * ws4.x + sh.x, v.y * ri * ws4.y + sh.y, v.z * ri * ws4.z + sh.z, v.w * ri * ws4.w + sh.w) \
                   : make_float4(0.f, 0.f, 0.f, 0.f);                                            \
        }
        NROW(hr0, 0) NROW(hr1, 1) NROW(hr2, 2) NROW(hr3, 3) NROW(hr4, 4) NROW(hr5, 5)
#undef NROW
#define MIX1(ha, hh, hb, j)                                                                      \
          {                                                                                      \
            float x0 = hh.x + (0.5f * (ha.x + hb.x) - hh.x) * m.x;                               \
            float x1 = hh.y + (0.5f * (ha.y + hb.y) - hh.y) * m.y;                               \
            float x2 = hh.z + (0.5f * (ha.z + hb.z) - hh.z) * m.z;                               \
            float x3 = hh.w + (0.5f * (ha.w + hb.w) - hh.w) * m.w;                               \
            *(uint2*)(dst + (long)(t0 + (j)) * 1024 + c) = make_uint2(pack2(x0, x1), pack2(x2, x3)); \
          }
#pragma unroll
        for (int n = 0; n < 6; ++n) {
          bf16_t* dst = (n == 0) ? (bf16_t*)(p.ws + L1_XM) : (n == 2) ? (bf16_t*)(p.ws + L1_XM + 20 * MIB) : (n == 3) ? (bf16_t*)(p.ws + L1_XM + 40 * MIB)
                      : (n == 5) ? (bf16_t*)(p.ws + L1_XM + 60 * MIB) : (n == 1) ? (bf16_t*)(p.ws + L1_XW) : (bf16_t*)(p.ws + L1_XW + 20 * MIB);
          const float4 m = *(const float4*)(mu + n * 1024 + c);
          MIX1(hr0, hr1, hr2, 0)
          MIX1(hr1, hr2, hr3, 1)
          MIX1(hr2, hr3, hr4, 2)
          MIX1(hr3, hr4, hr5, 3)
        }
#undef MIX1
      }
    }
  }
}

__device__ __forceinline__ void final_norm_phase(const Params& p) {
  const int lane = threadIdx.x & 63;
  const int gw = blockIdx.x * 4 + (threadIdx.x >> 6), nw = gridDim.x * 4;
  const float* fw = p.in[13];
  for (int t = gw; t < T_; t += nw) {
    float* x = p.out + (long)t * 1024;
    float4 v[4];
    float ss = 0.f;
#pragma unroll
    for (int it = 0; it < 4; ++it) {
      v[it] = *(const float4*)(x + it * 256 + lane * 4);
      ss += v[it].x * v[it].x + v[it].y * v[it].y + v[it].z * v[it].z + v[it].w * v[it].w;
    }
    ss = wave_sum(ss);
    float rinv = rsqrtf(ss * (1.f / 1024.f) + 1e-6f);
#pragma unroll
    for (int it = 0; it < 4; ++it) {
      float4 w = *(const float4*)(fw + it * 256 + lane * 4);
      *(float4*)(x + it * 256 + lane * 4) = make_float4(v[it].x * rinv * w.x, v[it].y * rinv * w.y, v[it].z * rinv * w.z, v[it].w * rinv * w.w);
    }
  }
}

__device__ __forceinline__ void ret_ln_phase(const Params& p) {
  const int lane = threadIdx.x & 63;
  const int gw = blockIdx.x * 4 + (threadIdx.x >> 6), nw = gridDim.x * 4;
  const bf16_t* O = (const bf16_t*)(p.ws + L0_O);
  const bf16_t* G = (const bf16_t*)(p.ws + L0_G);
  bf16_t* OB = (bf16_t*)(p.ws + OFF_OB);
  const float* gn = p.in[16];
  for (int item = gw; item < T_ * 4; item += nw) {
    long base = (long)item * 512 + lane * 8;
    const uint4 oh = *(const uint4*)(O + base);
    float4 a = make_float4(bf2f(oh.x & 0xffff), bf2f(oh.x >> 16), bf2f(oh.y & 0xffff), bf2f(oh.y >> 16));
    float4 b = make_float4(bf2f(oh.z & 0xffff), bf2f(oh.z >> 16), bf2f(oh.w & 0xffff), bf2f(oh.w >> 16));
    float s = a.x + a.y + a.z + a.w + b.x + b.y + b.z + b.w;
    float mean = wave_sum(s) * (1.f / 512.f);
    a.x -= mean; a.y -= mean; a.z -= mean; a.w -= mean; b.x -= mean; b.y -= mean; b.z -= mean; b.w -= mean;
    float vs = a.x * a.x + a.y * a.y + a.z * a.z + a.w * a.w + b.x * b.x + b.y * b.y + b.z * b.z + b.w * b.w;
    float rinv = rsqrtf(wave_sum(vs) * (1.f / 512.f) + 1e-5f);
    int col = (item & 3) * 512 + lane * 8;
    uint4 gg = *(const uint4*)(G + base);
    float4 w0 = *(const float4*)(gn + col), w1 = *(const float4*)(gn + col + 4);
    uint4 o;
    o.x = pack2(a.x * rinv * w0.x * silu_f(bf2f(gg.x & 0xffff)), a.y * rinv * w0.y * silu_f(bf2f(gg.x >> 16)));
    o.y = pack2(a.z * rinv * w0.z * silu_f(bf2f(gg.y & 0xffff)), a.w * rinv * w0.w * silu_f(bf2f(gg.y >> 16)));
    o.z = pack2(b.x * rinv * w1.x * silu_f(bf2f(gg.z & 0xffff)), b.y * rinv * w1.y * silu_f(bf2f(gg.z >> 16)));
    o.w = pack2(b.z * rinv * w1.z * silu_f(bf2f(gg.w & 0xffff)), b.w * rinv * w1.w * silu_f(bf2f(gg.w >> 16)));
    *(uint4*)(OB + base) = o;
  }
}

__device__ __forceinline__ float dpp_xor1(float x) {
  return __builtin_bit_cast(float, __builtin_amdgcn_mov_dpp(__builtin_bit_cast(int, x), 0xB1, 0xF, 0xF, true));
}
__device__ __forceinline__ float dpp_xor2(float x) {
  return __builtin_bit_cast(float, __builtin_amdgcn_mov_dpp(__builtin_bit_cast(int, x), 0x4E, 0xF, 0xF, true));
}
__device__ __forceinline__ float dpp_hmirror(float x) {
  return __builtin_bit_cast(float, __builtin_amdgcn_mov_dpp(__builtin_bit_cast(int, x), 0x141, 0xF, 0xF, true));
}
__device__ __forceinline__ float red8(float x) {
  x += dpp_xor1(x);
  x += dpp_xor2(x);
  x += dpp_hmirror(x);
  return x;
}
template <int R>
__device__ __forceinline__ void rwkv_scan_item(const Params& p, int sample, int bb, int h, int dir, int half, char* smem) {
  char* ws = p.ws;
  float* sm = (float*)smem;
  const int tid = threadIdx.x;
  int L = sample ? 1024 : 256;
  int tok0 = sample ? TP_ + bb * 1024 : bb * 256;
  const int rp = tid >> 3, kq = tid & 7;
  const int row0 = (R == 2) ? 2 * rp : half * 32 + rp;
  v2f P[8];
#pragma unroll
  for (int i = 0; i < 8; ++i) P[i] = (v2f)(0.f);
  if (sample) {
    const float* s0 = p.in[3] + (((long)(bb * 2 + dir) * 16 + h) * 64 + row0) * 64 + kq * 8;
    if (R == 2) {
#pragma unroll
      for (int i = 0; i < 8; ++i) { P[i].x = s0[i]; P[i].y = s0[64 + i]; }
    } else {
#pragma unroll
      for (int j = 0; j < 4; ++j) { P[j].x = s0[2 * j]; P[j].y = s0[2 * j + 1]; }
    }
  }
  const bf16_t* RKVG = (const bf16_t*)(ws + L1_RKVG);
  const bf16_t* DEC = (const bf16_t*)(ws + L1_DEC) + (long)dir * T_ * 1024;
  const bf16_t* AA = (const bf16_t*)(ws + L1_AA) + (long)dir * T_ * 1024;
  float* Y = (float*)(ws + L1_Y) + (long)dir * T_ * 1024;
  const int ch = tid & 63, col = h * 64 + ch, sw = tid >> 6;
  const float kkw = p.in[26][col];
  const float kaw = p.in[27][col];
  const int nch = L >> 4;
  float rr[4], rk[4], rv[4], rwd[4], ra[4];
#define SCAN_LOAD(c)                                                        \
  _Pragma("unroll") for (int i = 0; i < 4; ++i) {                           \
    int pos = (c) * 16 + sw + i * 4;                                        \
    int t = dir ? (L - 1 - pos) : pos;                                      \
    long tok = tok0 + t;                                                    \
    rr[i] = bf2f(RKVG[tok * 4096 + col]);                                   \
    rk[i] = bf2f(RKVG[tok * 4096 + 1024 + col]);                            \
    rv[i] = bf2f(RKVG[tok * 4096 + 2048 + col]);                            \
    rwd[i] = __expf(-bf2f(DEC[tok * 1024 + col]));                          \
    ra[i] = bf2f(AA[tok * 1024 + col]);                                     \
  }
#define SCAN_PREP(buf)                                                      \
  _Pragma("unroll") for (int i = 0; i < 4; ++i) {                           \
    float* b = sm + (buf) * 6144 + (sw + i * 4) * 64 + ch;                  \
    float kkr = rk[i] * kkw;                                                \
    float ss = wave_sum(kkr * kkr);                                         \
    float kk = kkr * rsqrtf(fmaxf(ss, 1e-12f));                             \
    b[0] = rr[i]; b[1024] = rwd[i]; b[2048] = kk; b[3072] = kk * ra[i];     \
    b[4096] = rk[i] * (1.f + (ra[i] - 1.f) * kaw); b[5120] = rv[i];         \
  }
#define YFLUSH(cc)                                                                   \
  {                                                                                  \
    constexpr int QPR = (R == 2) ? 16 : 8;                     \
    if (tid < 16 * QPR) {                                                            \
      const int s_ = tid / QPR, q_ = tid - s_ * QPR;                                 \
      const int pos_ = (cc) * 16 + s_;                                               \
      const int t_ = dir ? (L - 1 - pos_) : pos_;                                    \
      const float4 yv = *(const float4*)(sm + 12288 + ((cc) & 1) * 1024 + s_ * 64 + q_ * 4); \
      *(float4*)(Y + (long)(tok0 + t_) * 1024 + h * 64 + ((R == 2) ? 0 : half * 32) + q_ * 4) = yv; \
    }                                                                                \
  }
  __syncthreads();
  SCAN_LOAD(0)
  SCAN_PREP(0)
  for (int c = 0; c < nch; ++c) {
    const int buf = c & 1;
    if (c + 1 < nch) SCAN_LOAD(c + 1)
    __syncthreads();
    if (c > 0) YFLUSH(c - 1)
    const float* bs = sm + buf * 6144;
    float4 n_kk0, n_kk1, n_w0, n_w1, n_ka0, n_ka1, n_kd0, n_kd1, n_r0, n_r1; float n_vx, n_vy = 0.f;
#define STEP_LOAD(s)                                                              \
    {                                                                             \
      const float* o = bs + (s) * 64 + kq * 8;                                    \
      n_kk0 = *(const float4*)(o + 2048); n_kk1 = *(const float4*)(o + 2052);     \
      n_w0 = *(const float4*)(o + 1024); n_w1 = *(const float4*)(o + 1028);       \
      n_ka0 = *(const float4*)(o + 3072); n_ka1 = *(const float4*)(o + 3076);     \
      n_kd0 = *(const float4*)(o + 4096); n_kd1 = *(const float4*)(o + 4100);     \
      n_r0 = *(const float4*)(o); n_r1 = *(const float4*)(o + 4);                 \
      if (R == 2) { const float2 vv = *(const float2*)(bs + 5120 + (s) * 64 + row0); n_vx = vv.x; n_vy = vv.y; } \
      else n_vx = bs[5120 + (s) * 64 + row0];                                     \
    }
    STEP_LOAD(0)
#pragma unroll
    for (int s = 0; s < 16; ++s) {
      const float4 kka = n_kk0, kkb = n_kk1, wa = n_w0, wb = n_w1, ka = n_ka0, kb = n_ka1, da = n_kd0, db = n_kd1, ra4 = n_r0, rb4 = n_r1;
      const float vx = n_vx, vy = n_vy;
      if (s + 1 < 16) STEP_LOAD(s + 1)
      const float kkv[8] = {kka.x, kka.y, kka.z, kka.w, kkb.x, kkb.y, kkb.z, kkb.w};
      const float wv[8] = {wa.x, wa.y, wa.z, wa.w, wb.x, wb.y, wb.z, wb.w};
      const float kv[8] = {ka.x, ka.y, ka.z, ka.w, kb.x, kb.y, kb.z, kb.w};
      const float dv[8] = {da.x, da.y, da.z, da.w, db.x, db.y, db.z, db.w};
      const float rv8[8] = {ra4.x, ra4.y, ra4.z, ra4.w, rb4.x, rb4.y, rb4.z, rb4.w};
      float y0, y1 = 0.f;
      if (R == 2) {
        v2f dA = P[0] * (v2f)(kkv[0]), dB = P[1] * (v2f)(kkv[1]);
#pragma unroll
        for (int i = 2; i < 8; i += 2) { dA += P[i] * (v2f)(kkv[i]); dB += P[i + 1] * (v2f)(kkv[i + 1]); }
        const v2f d = dA + dB;
        v2f sa; sa.x = -red8(d.x); sa.y = -red8(d.y);
        v2f vv; vv.x = vx; vv.y = vy;
        v2f yA = (v2f)(0.f), yB = (v2f)(0.f);
#pragma unroll
        for (int i = 0; i < 8; i += 2) {
          P[i] = P[i] * (v2f)(wv[i]) + (sa * (v2f)(kv[i]) + vv * (v2f)(dv[i]));
          P[i + 1] = P[i + 1] * (v2f)(wv[i + 1]) + (sa * (v2f)(kv[i + 1]) + vv * (v2f)(dv[i + 1]));
          yA += P[i] * (v2f)(rv8[i]); yB += P[i + 1] * (v2f)(rv8[i + 1]);
        }
        const v2f yy = yA + yB;
        y0 = red8(yy.x); y1 = red8(yy.y);
      } else {
        v2f dA = P[0] * (v2f){kkv[0], kkv[1]} + P[2] * (v2f){kkv[4], kkv[5]};
        v2f dB = P[1] * (v2f){kkv[2], kkv[3]} + P[3] * (v2f){kkv[6], kkv[7]};
        const v2f d = dA + dB;
        const float sa = -red8(d.x + d.y);
        v2f yA = (v2f)(0.f), yB = (v2f)(0.f);
#pragma unroll
        for (int j = 0; j < 4; j += 2) {
          P[j] = P[j] * (v2f){wv[2 * j], wv[2 * j + 1]} + ((v2f)(sa) * (v2f){kv[2 * j], kv[2 * j + 1]} + (v2f)(vx) * (v2f){dv[2 * j], dv[2 * j + 1]});
          P[j + 1] = P[j + 1] * (v2f){wv[2 * j + 2], wv[2 * j + 3]} + ((v2f)(sa) * (v2f){kv[2 * j + 2], kv[2 * j + 3]} + (v2f)(vx) * (v2f){dv[2 * j + 2], dv[2 * j + 3]});
          yA += P[j] * (v2f){rv8[2 * j], rv8[2 * j + 1]}; yB += P[j + 1] * (v2f){rv8[2 * j + 2], rv8[2 * j + 3]};
        }
        const v2f yy = yA + yB;
        y0 = red8(yy.x + yy.y);
      }
      if (kq == 0) {
        float* yb = sm + 12288 + buf * 1024 + s * 64 + ((R == 2) ? 2 * rp : rp);
        if (R == 2) *(float2*)yb = make_float2(y0, y1);
        else *yb = y0;
      }
    }
#undef STEP_LOAD
    if (c + 1 < nch) SCAN_PREP(buf ^ 1)
  }
  __syncthreads();
  YFLUSH(nch - 1)
#undef YFLUSH
#undef SCAN_LOAD
#undef SCAN_PREP
  if (!sample) {
    float* so = p.out + OUT_STATE_RWKV + (((long)(bb * 2 + dir) * 16 + h) * 64 + row0) * 64 + kq * 8;
    if (R == 2) {
      *(float4*)(so) = make_float4(P[0].x, P[1].x, P[2].x, P[3].x);
      *(float4*)(so + 4) = make_float4(P[4].x, P[5].x, P[6].x, P[7].x);
      *(float4*)(so + 64) = make_float4(P[0].y, P[1].y, P[2].y, P[3].y);
      *(float4*)(so + 68) = make_float4(P[4].y, P[5].y, P[6].y, P[7].y);
    } else {
      *(float4*)(so) = make_float4(P[0].x, P[0].y, P[1].x, P[1].y);
      *(float4*)(so + 4) = make_float4(P[2].x, P[2].y, P[3].x, P[3].y);
    }
  }
}
__device__ __forceinline__ void deferred_transposes(const Params& p, char* smem, int worker, int nworkers) {
  int base = 0, tile = worker;
  for (int j = 4; j <= 7; ++j) {
    TJob t = tjob(p, j);
    int nt = (t.K >> 6) * (t.N >> 6);
    while (tile < base + nt) { transpose_tile(t, tile - base, smem); tile += nworkers; }
    base += nt;
  }
  __syncthreads();
}
__device__ __forceinline__ void rwkv_scan_phase(const Params& p, char* smem) {
  const int nb = gridDim.x, b = blockIdx.x;
  if (nb == 512) {
    if (b < 128) { int sc = b >> 1; rwkv_scan_item<1>(p, 1, sc >> 5, (sc >> 1) & 15, sc & 1, b & 1, smem); }
    else
      for (int it = b - 128; it < 1024; it += nb - 128) rwkv_scan_item<2>(p, 0, it >> 5, (it >> 1) & 15, it & 1, 0, smem);
    if (b < 128) { deferred_transposes(p, smem, b, 256); mod_gemv_items(p, smem, 384, 768, b, 256); }
    else if (b >= 384) { deferred_transposes(p, smem, 128 + (b - 384), 256); mod_gemv_items(p, smem, 384, 768, 128 + (b - 384), 256); }
  } else if (nb >= 256) {
    if (b < 128) { int sc = b >> 1; rwkv_scan_item<1>(p, 1, sc >> 5, (sc >> 1) & 15, sc & 1, b & 1, smem); }
    else
      for (int it = b - 128; it < 1024; it += nb - 128) rwkv_scan_item<2>(p, 0, it >> 5, (it >> 1) & 15, it & 1, 0, smem);
  } else {
    for (int it = b; it < 1088; it += nb) {
      if (it < 64) rwkv_scan_item<2>(p, 1, it >> 5, (it >> 1) & 15, it & 1, 0, smem);
      else { int i2 = it - 64; rwkv_scan_item<2>(p, 0, i2 >> 5, (i2 >> 1) & 15, i2 & 1, 0, smem); }
    }
  }
}
__device__ __forceinline__ float row_sum(float v) {
  v += DPPF(v, 0xB1);
  v += DPPF(v, 0x4E);
  v += DPPF(v, 0x141);
  v += DPPF(v, 0x140);
  return v;
}
__device__ __forceinline__ void rwkv_post_phase(const Params& p) {
  char* ws = p.ws;
  const int lane = threadIdx.x & 63;
  const int gw = blockIdx.x * 4 + (threadIdx.x >> 6), nw = gridDim.x * 4;
  const bf16_t* RKVG = (const bf16_t*)(ws + L1_RKVG);
  const bf16_t* AA = (const bf16_t*)(ws + L1_AA);
  const float* Y = (const float*)(ws + L1_Y);
  bf16_t* OB = (bf16_t*)(ws + OFF_OB);
  for (int item = gw; item < T_ * 4; item += nw) {
    const long t = item >> 2;
    const int c0 = (item & 3) * 256 + lane * 4;
    const uint2 r2 = *(const uint2*)(RKVG + t * 4096 + c0);
    const uint2 k2 = *(const uint2*)(RKVG + t * 4096 + 1024 + c0);
    const uint2 v2 = *(const uint2*)(RKVG + t * 4096 + 2048 + c0);
    const uint2 g2 = *(const uint2*)(RKVG + t * 4096 + 3072 + c0);
    const uint2 a0h = *(const uint2*)(AA + t * 1024 + c0);
    const uint2 a1h = *(const uint2*)(AA + (long)T_ * 1024 + t * 1024 + c0);
    const float4 y0 = *(const float4*)(Y + t * 1024 + c0);
    const float4 y1 = *(const float4*)(Y + (long)T_ * 1024 + t * 1024 + c0);
    const float4 ka = *(const float4*)(p.in[27] + c0);
    const float4 rk = *(const float4*)(p.in[28] + c0);
    const float4 gn = *(const float4*)(p.in[29] + c0);
    const float r[4] = {bf2f(r2.x & 0xffff), bf2f(r2.x >> 16), bf2f(r2.y & 0xffff), bf2f(r2.y >> 16)};
    const float k[4] = {bf2f(k2.x & 0xffff), bf2f(k2.x >> 16), bf2f(k2.y & 0xffff), bf2f(k2.y >> 16)};
    const float v[4] = {bf2f(v2.x & 0xffff), bf2f(v2.x >> 16), bf2f(v2.y & 0xffff), bf2f(v2.y >> 16)};
    const float g[4] = {bf2f(g2.x & 0xffff), bf2f(g2.x >> 16), bf2f(g2.y & 0xffff), bf2f(g2.y >> 16)};
    const float as[4] = {bf2f(a0h.x & 0xffff) + bf2f(a1h.x & 0xffff), bf2f(a0h.x >> 16) + bf2f(a1h.x >> 16),
                         bf2f(a0h.y & 0xffff) + bf2f(a1h.y & 0xffff), bf2f(a0h.y >> 16) + bf2f(a1h.y >> 16)};
    const float kav[4] = {ka.x, ka.y, ka.z, ka.w};
    const float rkv[4] = {rk.x, rk.y, rk.z, rk.w};
    const float gnv[4] = {gn.x, gn.y, gn.z, gn.w};
    float y[4] = {y0.x + y1.x, y0.y + y1.y, y0.z + y1.z, y0.w + y1.w};
    float bs = 0.f, ys = 0.f;
#pragma unroll
    for (int e = 0; e < 4; ++e) {
      bs += r[e] * (k[e] * (2.f + (as[e] - 2.f) * kav[e])) * rkv[e];
      ys += y[e];
    }
    const float bsum = row_sum(bs);
    const float mean = row_sum(ys) * (1.f / 64.f);
    float vs = 0.f;
#pragma unroll
    for (int e = 0; e < 4; ++e) { y[e] -= mean; vs += y[e] * y[e]; }
    const float rinv = rsqrtf(row_sum(vs) * (1.f / 64.f) + 1e-5f);
    float o[4];
#pragma unroll
    for (int e = 0; e < 4; ++e) o[e] = (y[e] * rinv * gnv[e] + bsum * v[e]) * silu_f(g[e]);
    *(uint2*)(OB + t * 1024 + c0) = make_uint2(pack2(o[0], o[1]), pack2(o[2], o[3]));
  }
}

__device__ __forceinline__ float diff_lambda(const Params& p, int lane, float lam_init) {
  const float* lp = p.in[32];
  float a = wave_sum(lp[lane] * lp[64 + lane]);
  float b = wave_sum(lp[128 + lane] * lp[192 + lane]);
  return __expf(a) - __expf(b) + lam_init;
}
#define LAM_INIT_2 0.47071302f

template <int NC, int DV, bool sample>
__device__ __forceinline__ void attn_item(const Params& p, int seq, int h, int qb, float lam, char* smem) {
  constexpr bool NA = (NC == 1);
  constexpr int KW = NC * 64;
  constexpr int NH = 1024 / KW;
  constexpr int KS = 72;
  constexpr int VS = 72;
  constexpr int NDT = DV / 16;
  constexpr int OSS = DV + 4;
  char* ws = p.ws;
  bf16_t* Ks = (bf16_t*)smem;
  bf16_t* Vs = Ks + 64 * KS;
  float* Os = (float*)(Vs + DV * VS);
  const int tid = threadIdx.x, lane = tid & 63, w = tid >> 6, l15 = lane & 15, q4 = lane >> 4;
  constexpr int Lk = sample ? 1280 : 256;
  const long tok0 = sample ? (long)TP_ + seq * 1024 : (long)seq * 256;
  const long q_tok = tok0 + qb * 64 + w * 16 + l15;
  constexpr int kstride = sample ? KW : 1024;
  const bf16_t* Kb = sample ? (const bf16_t*)(ws + L2_KALL) + (long)(seq * NH + h) * 1280 * KW
                            : (const bf16_t*)(ws + L2_KP) + tok0 * 1024 + h * KW;
  const bf16_t* Vb = sample ? (const bf16_t*)(ws + L2_VTS) + (long)(seq * NH + h) * DV * 1280
                            : (const bf16_t*)(ws + L2_VTP) + (long)(seq * NH + h) * DV * 256;
  const int rs = min(max(qb - 4, 0), 8);
  const int qc = w * 16 + l15;
  const int cs = min(max(qc - 8, 0), 48);
  const float* bt = p.in[36] + h * 465;
  constexpr int ntiles = (NA && sample) ? 12 : (Lk >> 6);
  f32x4 O[NDT];
  float lsum = 0.f;
  bf16x8 qf[2];
  float mrun = -INFINITY, lrun = 0.f;
  constexpr int npass = NC * ntiles;
  uint4 kr0, kr1, vr0, vr1, vr2 = make_uint4(0, 0, 0, 0), vr3 = make_uint4(0, 0, 0, 0);
  const int ldrow = tid >> 3, ldch = tid & 7;
#define ATT_LOAD(pi)                                                                                   \
  {                                                                                                    \
    const int c_ = (pi) / ntiles, ti_ = (pi) - c_ * ntiles;                                            \
    const int kt_ = (NA && sample) ? (ti_ < 8 ? rs + ti_ : 8 + ti_) : ti_;                             \
    const int key0_ = kt_ * 64;                                                                        \
    kr0 = *(const uint4*)(Kb + (long)(key0_ + ldrow) * kstride + c_ * 64 + ldch * 8);                  \
    kr1 = *(const uint4*)(Kb + (long)(key0_ + ldrow + 32) * kstride + c_ * 64 + ldch * 8);             \
    vr0 = *(const uint4*)(Vb + (long)ldrow * Lk + key0_ + ldch * 8);                                   \
    vr1 = *(const uint4*)(Vb + (long)(ldrow + 32) * Lk + key0_ + ldch * 8);                            \
    if (DV > 64) {                                                                                     \
      vr2 = *(const uint4*)(Vb + (long)(ldrow + 64) * Lk + key0_ + ldch * 8);                          \
      vr3 = *(const uint4*)(Vb + (long)(ldrow + 96) * Lk + key0_ + ldch * 8);                          \
    }                                                                                                  \
  }
  ATT_LOAD(0)
#pragma unroll 1
  for (int pi = 0; pi < npass; ++pi) {
    const int c = pi / ntiles, ti = pi - c * ntiles;
    if (ti == 0) {
      const bf16_t* Q = (const bf16_t*)(ws + L2_Q) + q_tok * 1024 + h * KW + c * 64;
      qf[0] = *(const bf16x8*)(Q + q4 * 8);
      qf[1] = *(const bf16x8*)(Q + 32 + q4 * 8);
      mrun = -INFINITY; lrun = 0.f;
#pragma unroll
      for (int dt = 0; dt < NDT; ++dt) O[dt] = (f32x4){0.f, 0.f, 0.f, 0.f};
    }
    const int kt = (NA && sample) ? (ti < 8 ? rs + ti : 8 + ti) : ti;
    __syncthreads();
    *(uint4*)(Ks + ldrow * KS + ldch * 8) = kr0;
    *(uint4*)(Ks + (ldrow + 32) * KS + ldch * 8) = kr1;
    *(uint4*)(Vs + ldrow * VS + ldch * 8) = vr0;
    *(uint4*)(Vs + (ldrow + 32) * VS + ldch * 8) = vr1;
    if (DV > 64) {
      *(uint4*)(Vs + (ldrow + 64) * VS + ldch * 8) = vr2;
      *(uint4*)(Vs + (ldrow + 96) * VS + ldch * 8) = vr3;
    }
    __syncthreads();
    if (pi + 1 < npass) ATT_LOAD(pi + 1)
    {
      f32x4 s[4];
#pragma unroll
      for (int st = 0; st < 4; ++st) {
        s[st] = (f32x4){0.f, 0.f, 0.f, 0.f};
#pragma unroll
        for (int ks = 0; ks < 2; ++ks) {
          bf16x8 a = *(const bf16x8*)(Ks + (st * 16 + l15) * KS + ks * 32 + q4 * 8);
          s[st] = __builtin_amdgcn_mfma_f32_16x16x32_f16(a, qf[ks], s[st], 0, 0, 0);
        }
      }
      float mx = -INFINITY;
#pragma unroll
      for (int st = 0; st < 4; ++st)
#pragma unroll
        for (int j = 0; j < 4; ++j) {
          float val = s[st][j] * 0.125f;
          if (NA && sample && kt < 16) {
            int kc = st * 16 + q4 * 4 + j;
            bool ok = (kc >= cs) && (kc < cs + 16);
            int ro = kt - qb + 7;
            int co = min(max(kc - qc, -15), 15) + 15;
            val = ok ? val + bt[ro * 31 + co] : -INFINITY;
          }
          s[st][j] = val;
          mx = fmaxf(mx, val);
        }
      mx = fmaxf(mx, __shfl_xor(mx, 16));
      mx = fmaxf(mx, __shfl_xor(mx, 32));
      const float mnew = fmaxf(mrun, mx);
      const float alpha = __expf(mrun - mnew);
      mrun = mnew;
      float psum = 0.f;
#pragma unroll
      for (int st = 0; st < 4; ++st)
#pragma unroll
        for (int j = 0; j < 4; ++j) {
          float pv = __expf(s[st][j] - mnew);
          s[st][j] = pv;
          psum += pv;
        }
      lrun = lrun * alpha + psum;
#pragma unroll
      for (int dt = 0; dt < NDT; ++dt) {
        O[dt][0] *= alpha; O[dt][1] *= alpha; O[dt][2] *= alpha; O[dt][3] *= alpha;
      }
#pragma unroll
      for (int pp = 0; pp < 2; ++pp) {
        bf16x8 pf;
#pragma unroll
        for (int j = 0; j < 4; ++j) { pf[j] = (_Float16)s[2 * pp][j]; pf[4 + j] = (_Float16)s[2 * pp + 1][j]; }
#pragma unroll
        for (int dt = 0; dt < NDT; ++dt) {
          const bf16_t* vr = Vs + (dt * 16 + l15) * VS + pp * 32 + q4 * 4;
          uint2 lo = *(const uint2*)vr, hi = *(const uint2*)(vr + 16);
          uint4 av = make_uint4(lo.x, lo.y, hi.x, hi.y);
          O[dt] = __builtin_amdgcn_mfma_f32_16x16x32_f16(__builtin_bit_cast(bf16x8, av), pf, O[dt], 0, 0, 0);
        }
      }
    }
    if (ti == ntiles - 1) {
      lrun += __shfl_xor(lrun, 16);
      lrun += __shfl_xor(lrun, 32);
      lsum = lrun;
      if (!NA && c == 0) {
        const float il = __builtin_amdgcn_rcpf(lrun);
        float* os = Os + (w * 16 + l15) * OSS + q4 * 4;
#pragma unroll
        for (int dt = 0; dt < NDT; ++dt)
          *(float4*)(os + dt * 16) = make_float4(O[dt][0] * il, O[dt][1] * il, O[dt][2] * il, O[dt][3] * il);
      }
    }
  }
#undef ATT_LOAD
  const bf16_t* G = (const bf16_t*)(ws + L2_G) + q_tok * 1024 + h * DV;
  bf16_t* OB = (bf16_t*)(ws + OFF_OB) + q_tok * 1024 + h * DV;
  if (NA) {
    const float il = __builtin_amdgcn_rcpf(lsum);
#pragma unroll
    for (int dt = 0; dt < NDT; ++dt) {
      int dv = dt * 16 + q4 * 4;
      uint2 gg = *(const uint2*)(G + dv);
      float g0 = bf2f(gg.x & 0xffff), g1 = bf2f(gg.x >> 16), g2 = bf2f(gg.y & 0xffff), g3 = bf2f(gg.y >> 16);
      *(uint2*)(OB + dv) = make_uint2(pack2(O[dt][0] * il * silu_f(g0), O[dt][1] * il * silu_f(g1)),
                                      pack2(O[dt][2] * il * silu_f(g2), O[dt][3] * il * silu_f(g3)));
    }
  } else {
    const float i1 = lam * __builtin_amdgcn_rcpf(lsum);
    const float* os = Os + (w * 16 + l15) * OSS + q4 * 4;
    float ss = 0.f;
#pragma unroll
    for (int dt = 0; dt < NDT; ++dt) {
      float4 o0 = *(const float4*)(os + dt * 16);
      O[dt][0] = o0.x - O[dt][0] * i1; O[dt][1] = o0.y - O[dt][1] * i1;
      O[dt][2] = o0.z - O[dt][2] * i1; O[dt][3] = o0.w - O[dt][3] * i1;
      ss += O[dt][0] * O[dt][0] + O[dt][1] * O[dt][1] + O[dt][2] * O[dt][2] + O[dt][3] * O[dt][3];
    }
    ss += __shfl_xor(ss, 16);
    ss += __shfl_xor(ss, 32);
    const float rinv = rsqrtf(ss * (1.f / DV) + 1e-6f) * (1.f - LAM_INIT_2);
    const float* gn = p.in[33] + h * DV;
#pragma unroll
    for (int dt = 0; dt < NDT; ++dt) {
      int dv = dt * 16 + q4 * 4;
      uint2 gg = *(const uint2*)(G + dv);
      float4 gw = *(const float4*)(gn + dv);
      float g0 = bf2f(gg.x & 0xffff), g1 = bf2f(gg.x >> 16), g2 = bf2f(gg.y & 0xffff), g3 = bf2f(gg.y >> 16);
      *(uint2*)(OB + dv) = make_uint2(pack2(O[dt][0] * rinv * gw.x * silu_f(g0), O[dt][1] * rinv * gw.y * silu_f(g1)),
                                      pack2(O[dt][2] * rinv * gw.z * silu_f(g2), O[dt][3] * rinv * gw.w * silu_f(g3)));
    }
  }
}
__device__ __forceinline__ void diff_attn_phase(const Params& p, char* smem) {
  const int lane = threadIdx.x & 63;
  const float lam = diff_lambda(p, lane, LAM_INIT_2);
  const int b = blockIdx.x, nb = gridDim.x;
  const bool split = nb >= 512;
  int it = split ? (b < 256 ? b : 256 + (b - 256)) : b;
  const int step = split ? (b < 256 ? 1 << 30 : nb - 256) : nb;
  for (; it < 1280; it += step) {
    bool sample = it < 256;
    int i2 = sample ? it : it - 256;
    int seq = sample ? (i2 >> 7) : (i2 >> 5);
    int h = sample ? ((i2 >> 4) & 7) : ((i2 >> 2) & 7);
    int qb = sample ? (i2 & 15) : (i2 & 3);
    if (sample) attn_item<2, 128, true>(p, seq, h, qb, lam, smem);
    else attn_item<2, 128, false>(p, seq, h, qb, lam, smem);
    if (step == (1 << 30)) break;
  }
}
__device__ __forceinline__ void na_attn_phase(const Params& p, char* smem) {
  const int b = blockIdx.x, nb = gridDim.x;
  for (int it = b; it < 2560; it += nb) {
    bool sample = it < 512;
    int i2 = sample ? it : it - 512;
    int seq = sample ? (i2 >> 8) : (i2 >> 6);
    int h = sample ? ((i2 >> 4) & 15) : ((i2 >> 2) & 15);
    int qb = sample ? (i2 & 15) : (i2 & 3);
    if (sample) attn_item<1, 64, true>(p, seq, h, qb, 0.f, smem);
    else attn_item<1, 64, false>(p, seq, h, qb, 0.f, smem);
  }
}

#define OFF_BAR (512l * 1024)
#define XB_TMO      128
#define XB_XCNT(j)  (256  + 64 * (j))
#define XB_XSUB(j)  (1280 + 64 * (j))
#define XB_XGEN(j)  (2304 + 64 * (j))
#define XB_TOP      3328
#define XB_TOPGEN   3392
#define XB_RANK(j)  (3456 + 64 * (j))
#define XCD_BAR_WORDS 4480
#define XB_SPIN_CAP (1u << 20)
#define LAS __attribute__((address_space(3)))
__device__ __forceinline__ unsigned xb_ld(unsigned* p)              { return __hip_atomic_load(p, __ATOMIC_RELAXED, __HIP_MEMORY_SCOPE_AGENT); }
__device__ __forceinline__ unsigned xb_add(unsigned* p, unsigned v) { return __hip_atomic_fetch_add(p, v, __ATOMIC_RELAXED, __HIP_MEMORY_SCOPE_AGENT); }
__device__ __forceinline__ unsigned xb_xcc_id() { return (unsigned)__builtin_amdgcn_s_getreg((3 << 11) | 20) & 0xFu; }
#define XB_SPIN(cond, bar) do { unsigned _sp = 0; while (cond) { __builtin_amdgcn_s_sleep(1); \
    if ((++_sp & 255u) == 0u) { if (xb_ld(&(bar)[XB_TMO])) break; if (_sp > XB_SPIN_CAP) { atomicAdd(&(bar)[XB_TMO], 1u); break; } } } } while (0)
struct XcdBarrier { unsigned* bar; unsigned x; volatile LAS unsigned* st; };
__device__ __forceinline__ XcdBarrier xcd_barrier_post(unsigned* bar, volatile LAS unsigned* st) {
  XcdBarrier b; b.bar = bar; b.x = xb_xcc_id(); b.st = st;
  if (threadIdx.x == 0) (void)xb_add(&bar[XB_XCNT(b.x)], 1u);
  return b;
}
__device__ __forceinline__ void xcd_barrier_complete(unsigned* bar, unsigned x, unsigned& nloc, unsigned& nx) {
  const unsigned G = gridDim.x * gridDim.y * gridDim.z;
  unsigned sum, cnt, mine, sp = 0u;
  for (;;) {
    sum = 0u; cnt = 0u; mine = 0u;
#pragma unroll
    for (unsigned j = 0; j < 16; ++j) { const unsigned c = xb_ld(&bar[XB_XCNT(j)]); sum += c; cnt += (c > 0u) ? 1u : 0u; mine = (j == x) ? c : mine; }
    if (sum == G) break;
    __builtin_amdgcn_s_sleep(1);
    if ((++sp & 255u) == 0u) { if (xb_ld(&bar[XB_TMO])) break; if (sp > XB_SPIN_CAP) { atomicAdd(&bar[XB_TMO], 1u); break; } }
  }
  nloc = mine > 0u ? mine : 1u; nx = cnt > 0u ? cnt : 1u;
}
__device__ __forceinline__ void xcd_barrier(const XcdBarrier& b) {
  asm volatile("s_waitcnt vmcnt(0)" ::: "memory");
  __syncthreads();
  if (threadIdx.x == 0) {
    unsigned* bar = b.bar;
    __builtin_amdgcn_s_waitcnt(0);
    unsigned nloc = b.st[0], nx = b.st[1];
    if (nloc == 0u) { xcd_barrier_complete(bar, b.x, nloc, nx); b.st[0] = nloc; b.st[1] = nx; }
    const unsigned old = xb_add(&bar[XB_XSUB(b.x)], 1u);
    const unsigned gen = old / nloc;
    if (old + 1u == (gen + 1u) * nloc) {
      __builtin_amdgcn_fence(__ATOMIC_RELEASE, "agent");
      asm volatile("s_waitcnt vmcnt(0)" ::: "memory");
      const unsigned og = xb_add(&bar[XB_TOP], 1u);
      const unsigned tg = og / nx;
      if (og + 1u == (tg + 1u) * nx) xb_add(&bar[XB_TOPGEN], 1u);
      else XB_SPIN(xb_ld(&bar[XB_TOPGEN]) == tg, bar);
      __builtin_amdgcn_fence(__ATOMIC_ACQUIRE, "agent");
      xb_add(&bar[XB_XGEN(b.x)], 1u);
      asm volatile("s_waitcnt vmcnt(0)" ::: "memory");
    } else {
      XB_SPIN(xb_ld(&bar[XB_XGEN(b.x)]) == gen, bar);
      __builtin_amdgcn_fence(__ATOMIC_ACQUIRE, "agent");
      asm volatile("s_waitcnt vmcnt(0)" ::: "memory");
    }
  }
  __syncthreads();
}

#define N_PHASES 27
#define N_PHASES 22
#define GSYNC(k) { xcd_barrier(xb); }
#define PH(k, body)                                   \
  if (ph_lo <= (k) && (k) < ph_hi) { body; }          \
  if (ph_lo <= (k) && (k) + 1 < ph_hi) GSYNC(k)
__global__ void __launch_bounds__(256, 2) mega(Params p, int ph_lo, int ph_hi) {
  __shared__ __attribute__((aligned(16))) char smem[73728];
  __shared__ uint4 xb_words;
  cg::grid_group grid = cg::this_grid();
  unsigned* bar = (unsigned*)(p.ws + OFF_BAR);
  if (threadIdx.x == 0) xb_words = make_uint4(0u, 0u, 0u, 0u);
  __syncthreads();
  if (ph_lo < 0) grid.sync();
  XcdBarrier xb = xcd_barrier_post(bar, (volatile LAS unsigned*)&xb_words);
  int vb = blockIdx.x;
  PH(0, prep_phase(p, smem))
  PH(1, norm_phase(p, 0))
  PH(2, gemm_phase(p, 0, smem, vb); if (gridDim.x == 512) { transposes_subset(p, smem, 0xFF0Eu, blockIdx.x, 512); mod_gemv_items(p, smem, 192, 384, blockIdx.x, 512); })
  PH(3, gemm_phase(p, 1, smem, vb))
  PH(4, gemm_phase(p, 2, smem, vb))
  PH(5, ret_ln_phase(p))
  PH(6, gemm_phase(p, 3, smem, vb))
  PH(7, norm_phase(p, 1))
  PH(8, gemm_phase(p, 4, smem, vb))
  PH(9, gemm_phase(p, 5, smem, vb))
  PH(10, rwkv_scan_phase(p, smem))
  PH(11, rwkv_post_phase(p))
  PH(12, gemm_phase(p, 6, smem, vb))
  PH(13, norm_phase(p, 2); diff_cache_prep(p))
  PH(14, gemm_phase(p, 7, smem, vb))
  PH(15, diff_attn_phase(p, smem))
  PH(16, gemm_phase(p, 10, smem, vb))
  PH(17, norm_phase(p, 3); na_cache_prep(p))
  PH(18, gemm_phase(p, 11, smem, vb))
  PH(19, na_attn_phase(p, smem))
  PH(20, gemm_phase(p, 14, smem, vb))
  PH(21, final_norm_phase(p))
}

extern "C" void kernel_launch(void* const* d_in, const int* in_sizes, int n_in,
                              void* d_out, int out_size, void* d_ws, size_t ws_size,
                              hipStream_t stream) {
  static int grid_blocks = 0;
  if (!grid_blocks) {
    int dev = 0, cus = 0, per_cu = 0;
    (void)hipGetDevice(&dev);
    (void)hipDeviceGetAttribute(&cus, hipDeviceAttributeMultiprocessorCount, dev);
    (void)hipOccupancyMaxActiveBlocksPerMultiprocessor(&per_cu, mega, 256, 0);
    if (per_cu > 2) per_cu = 2;
    if (per_cu < 1) per_cu = 1;
    grid_blocks = cus * per_cu;
  }
  Params p{};
  for (int i = 0; i < 38; ++i) p.in[i] = (const float*)d_in[i];
  p.out = (float*)d_out;
  p.ws = (char*)d_ws;
  int lo = 0, hi = N_PHASES;
  (void)hipMemsetAsync((char*)d_ws + OFF_BAR, 0, XCD_BAR_WORDS * 4, stream);
  void* args[] = {&p, &lo, &hi};
  hipError_t e = hipLaunchCooperativeKernel((void*)mega, dim3(grid_blocks), dim3(256), args, 0, stream);
  if (e != hipSuccess) fprintf(stderr, "cooperative launch failed: %s (grid %d)\n", hipGetErrorString(e), grid_blocks);
}
```

```cpp
#include <hip/hip_runtime.h>
#include <hip/hip_cooperative_groups.h>
#include <cstdio>
namespace cg = cooperative_groups;

typedef unsigned short bf16_t;
using bf16x8 = __attribute__((ext_vector_type(8))) _Float16;
using f32x4 = __attribute__((ext_vector_type(4))) float;
typedef float v2f __attribute__((ext_vector_type(2)));

#define TP_ 8192
#define T_ 10240
#define MIB (1l << 20)

#define OFF_MOD 0l
#define OFF_TAB (256l * 1024)
#define OFF_WT_RET_IN (1 * MIB)
#define OFF_WT_RET_OUT (13 * MIB)
#define OFF_WT_RWKV_IN (17 * MIB)
#define OFF_WT_RWKV_OUT (25 * MIB)
#define OFF_WT_DIFF_IN (27 * MIB)
#define OFF_WT_DIFF_OUT (35 * MIB)
#define OFF_WT_NA_IN (37 * MIB)
#define OFF_WT_NA_OUT (45 * MIB)
#define OFF_WT_LDOWN (47 * MIB)
#define OFF_WT_LUP (47 * MIB + 512 * 1024)
#define ARENA (48 * MIB)
#define OFF_H (ARENA + 0 * MIB)
#define OFF_SH (ARENA + 20 * MIB)
#define OFF_OB (ARENA + 40 * MIB)
#define L0_Q (ARENA + 80 * MIB)
#define L0_K (ARENA + 100 * MIB)
#define L0_G (ARENA + 120 * MIB)
#define L0_VTP (ARENA + 160 * MIB)
#define L0_VTS (ARENA + 192 * MIB)
#define L0_KT (ARENA + 208 * MIB)
#define L0_SP (ARENA + 240 * MIB)
#define L0_PEXT (ARENA + 256 * MIB)
#define L0_O (ARENA + 280 * MIB)
#define L1_RKVG (ARENA + 80 * MIB)
#define L1_L (ARENA + 160 * MIB)
#define L1_DEC (ARENA + 168 * MIB)
#define L1_AA (ARENA + 248 * MIB)
#define L1_Y (ARENA + 328 * MIB)
#define L1_XM (ARENA + 0 * MIB)
#define L1_XW (ARENA + 328 * MIB)
#define L2_O (ARENA + 0 * MIB)
#define L2_Q (ARENA + 60 * MIB)
#define L2_KP (ARENA + 80 * MIB)
#define L2_G (ARENA + 100 * MIB)
#define L2_VTP (ARENA + 120 * MIB)
#define L2_VTS (ARENA + 136 * MIB)
#define L2_KALL (ARENA + 144 * MIB)
#define L2_S1P (ARENA + 152 * MIB)
#define L2_S2P (ARENA + 216 * MIB)
#define L2_S1S (ARENA + 280 * MIB)
#define L2_S2S (ARENA + 360 * MIB)
#define L3_SP (ARENA + 152 * MIB)
#define L3_SS (ARENA + 280 * MIB)

#define OUT_STATE_RET 10485760l
#define OUT_STATE_RWKV 44040192l
#define OUT_DIFF_K 48234496l
#define OUT_DIFF_V 56623104l
#define OUT_NA_K 65011712l
#define OUT_NA_V 73400320l

struct Params {
  const float* in[38];
  float* out;
  char* ws;
};

__device__ __forceinline__ bf16_t f2bf(float f) {
  _Float16 h = (_Float16)f;
  return __builtin_bit_cast(unsigned short, h);
}
__device__ __forceinline__ float bf2f(unsigned h) { return (float)__builtin_bit_cast(_Float16, (unsigned short)h); }
__device__ __forceinline__ unsigned pack2(float a, float b) { return (unsigned)f2bf(a) | ((unsigned)f2bf(b) << 16); }
#define DPPF(x, ctrl) __builtin_bit_cast(float, __builtin_amdgcn_mov_dpp(__builtin_bit_cast(int, (x)), (ctrl), 0xF, 0xF, true))
#define RDLANE(x, l) __builtin_bit_cast(float, __builtin_amdgcn_readlane(__builtin_bit_cast(int, (x)), (l)))
__device__ __forceinline__ float wave_sum(float v) {
  v += DPPF(v, 0xB1);
  v += DPPF(v, 0x4E);
  v += DPPF(v, 0x141);
  v += DPPF(v, 0x140);
  return (RDLANE(v, 0) + RDLANE(v, 16)) + (RDLANE(v, 32) + RDLANE(v, 48));
}
__device__ __forceinline__ float wave_max(float v) {
  v = fmaxf(v, DPPF(v, 0xB1));
  v = fmaxf(v, DPPF(v, 0x4E));
  v = fmaxf(v, DPPF(v, 0x141));
  v = fmaxf(v, DPPF(v, 0x140));
  return fmaxf(fmaxf(RDLANE(v, 0), RDLANE(v, 16)), fmaxf(RDLANE(v, 32), RDLANE(v, 48)));
}
__device__ __forceinline__ void nt_store4(float* ptr, float a, float b, float c, float d) {
  f32x4 v = {a, b, c, d};
  __builtin_nontemporal_store(v, (f32x4*)ptr);
}
__device__ __forceinline__ float silu_f(float x) { return x * __builtin_amdgcn_rcpf(1.f + __expf(-x)); }
__device__ __forceinline__ int perm_ret(int c) {
  int half = c >> 7, r = c & 127;
  return half * 128 + (r & 1) * 64 + (r >> 1);
}
__device__ __forceinline__ int perm_diff(int c) {
  int rr = c & 31;
  return (c & ~31) + (rr & 1) * 16 + (rr >> 1);
}

enum { EPI_F32 = 0, EPI_RET_IN, EPI_RET_S, EPI_OUT, EPI_BF16, EPI_LUP_W, EPI_LUP_A, EPI_DIFF_IN, EPI_NA_IN, EPI_NA_PV };

struct GemmDesc {
  const bf16_t* A; const bf16_t* B;
  long lda, ldb;
  int M, N, K;
  int nb1, nb2;
  long sA1, sA2, sB1, sB2;
  int epi, bn64, flag, layer;
  float* C; long ldc, sC1, sC2; float scale;
  const float* aux;
};

__device__ __forceinline__ void epilogue(const Params& p, const GemmDesc& g, int b1, int b2, int m, int n, f32x4 v) {
  char* ws = p.ws;
  switch (g.epi) {
    case EPI_F32: {
      int mm = m;
      if (g.flag & 1) mm = perm_ret(m);
      float4 o = make_float4(v[0] * g.scale, v[1] * g.scale, v[2] * g.scale, v[3] * g.scale);
      if (g.flag & 2) *(uint2*)((bf16_t*)g.C + b1 * g.sC1 + b2 * g.sC2 + (long)mm * g.ldc + n) = make_uint2(pack2(o.x, o.y), pack2(o.z, o.w));
      else if (g.flag & 1) nt_store4(g.C + b1 * g.sC1 + b2 * g.sC2 + (long)mm * g.ldc + n, o.x, o.y, o.z, o.w);
      else *(float4*)(g.C + b1 * g.sC1 + b2 * g.sC2 + (long)mm * g.ldc + n) = o;
    } break;
    case EPI_BF16: {
      float a0 = v[0], a1 = v[1], a2 = v[2], a3 = v[3];
      if (g.flag & 1) {
        a0 = 1.f - 2.f * __builtin_amdgcn_rcpf(__expf(2.f * a0) + 1.f); a1 = 1.f - 2.f * __builtin_amdgcn_rcpf(__expf(2.f * a1) + 1.f);
        a2 = 1.f - 2.f * __builtin_amdgcn_rcpf(__expf(2.f * a2) + 1.f); a3 = 1.f - 2.f * __builtin_amdgcn_rcpf(__expf(2.f * a3) + 1.f);
      }
      uint2 o = make_uint2(pack2(a0, a1), pack2(a2, a3));
      *(uint2*)((bf16_t*)g.C + (long)m * g.ldc + n) = o;
    } break;
    case EPI_OUT: {
      int cond = (m < TP_) ? 0 : 1 + ((m - TP_) >> 10);
      const float* gate = (const float*)(ws + OFF_MOD) + ((long)g.layer * 3 + cond) * 3072 + 2048 + n;
      const float* res;
      if (g.layer == 0) res = (m < TP_) ? p.in[0] + (long)m * 1024 + n : p.in[1] + (long)(m - TP_) * 1024 + n;
      else res = p.out + (long)m * 1024 + n;
      float4 r = *(const float4*)res;
      float4 gt = *(const float4*)gate;
      float4 o = make_float4(r.x + gt.x * v[0], r.y + gt.y * v[1], r.z + gt.z * v[2], r.w + gt.w * v[3]);
      *(float4*)(p.out + (long)m * 1024 + n) = o;
    } break;
    case EPI_LUP_W: {
      const float4 w4 = *(const float4*)(g.aux + n);
      const float w0[4] = {w4.x, w4.y, w4.z, w4.w};
      float o[4];
#pragma unroll
      for (int j = 0; j < 4; ++j) o[j] = 0.6065306597126334f * __builtin_amdgcn_rcpf(1.f + __expf(-(w0[j] + v[j])));
      *(uint2*)((bf16_t*)g.C + (long)m * 1024 + n) = make_uint2(pack2(o[0], o[1]), pack2(o[2], o[3]));
    } break;
    case EPI_LUP_A: {
      const float4 a4 = *(const float4*)(g.aux + n);
      const float a0[4] = {a4.x, a4.y, a4.z, a4.w};
      float o[4];
#pragma unroll
      for (int j = 0; j < 4; ++j) o[j] = __builtin_amdgcn_rcpf(1.f + __expf(-(a0[j] + v[j])));
      *(uint2*)((bf16_t*)g.C + (long)m * 1024 + n) = make_uint2(pack2(o[0], o[1]), pack2(o[2], o[3]));
    } break;
    case EPI_RET_IN: {
      const bool sample = m >= TP_;
      const int sb = (m - TP_) >> 10, ls = (m - TP_) & 1023;
      const int pb = m >> 8, lp = m & 255;
      const float* lg = (const float*)(ws + OFF_TAB);
      if (n < 2048) {
        const bool isk = n >= 1024;
        const int c = n & 1023, h = c >> 8, dk = c & 255;
        float x[4] = {v[0], v[1], v[2], v[3]};
        if (isk) { x[0] *= 0.0625f; x[1] *= 0.0625f; x[2] *= 0.0625f; x[3] *= 0.0625f; }
        if (sample) {
          const int half = dk >> 7;
          const float pos = half ? (float)(ls & 63) : (float)(ls >> 6);
#pragma unroll
          for (int pp = 0; pp < 2; ++pp) {
            int i = ((dk & 127) >> 1) + pp;
            float inv = __builtin_amdgcn_exp2f(-(float)i * (13.287712379549449f / 64.f));
            float ang = pos * inv;
            float cs = __cosf(ang), sn = __sinf(ang);
            float x1 = x[2 * pp], x2 = x[2 * pp + 1];
            x[2 * pp] = x1 * cs - x2 * sn;
            x[2 * pp + 1] = x1 * sn + x2 * cs;
          }
        }
        bf16_t* dst = (bf16_t*)(ws + (isk ? L0_K : L0_Q)) + (long)m * 1024 + c;
        *(uint2*)dst = make_uint2(pack2(x[0], x[1]), pack2(x[2], x[3]));
        if (sample && !isk) {
          float df = __expf(lg[h] * (float)(ls + 1));
          float db = __expf(lg[4 + h] * (float)(1024 - ls));
          bf16_t* pe = (bf16_t*)(ws + L0_PEXT) + ((long)(sb * 4 + h) * 1024 + ls) * 1536 + 1024 + dk;
          *(uint2*)pe = make_uint2(pack2(x[0] * df, x[1] * df), pack2(x[2] * df, x[3] * df));
          *(uint2*)(pe + 256) = make_uint2(pack2(x[0] * db, x[1] * db), pack2(x[2] * db, x[3] * db));
        }
        if (!sample && isk) {
          float df = __expf(lg[h] * (float)(255 - lp));
          float db = __expf(lg[4 + h] * (float)lp);
          bf16_t* kt0 = (bf16_t*)(ws + L0_KT) + ((long)((0 * 32 + pb) * 4 + h) * 256 + dk) * 256 + lp;
          bf16_t* kt1 = (bf16_t*)(ws + L0_KT) + ((long)((1 * 32 + pb) * 4 + h) * 256 + dk) * 256 + lp;
#pragma unroll
          for (int j = 0; j < 4; ++j) { kt0[j * 256] = f2bf(x[j] * df); kt1[j * 256] = f2bf(x[j] * db); }
        }
      } else if (n < 4096) {
        const int c = n - 2048, h = c >> 9, dv = c & 511;
        if (sample) {
          bf16_t* vt = (bf16_t*)(ws + L0_VTS) + ((long)(sb * 4 + h) * 512 + dv) * 1536 + ls;
#pragma unroll
          for (int j = 0; j < 4; ++j) vt[j * 1536] = f2bf(v[j]);
        } else {
          bf16_t* vt = (bf16_t*)(ws + L0_VTP) + ((long)(pb * 4 + h) * 512 + dv) * 256 + lp;
#pragma unroll
          for (int j = 0; j < 4; ++j) vt[j * 256] = f2bf(v[j]);
        }
      } else {
        bf16_t* dst = (bf16_t*)(ws + L0_G) + (long)m * 2048 + (n - 4096);
        *(uint2*)dst = make_uint2(pack2(v[0], v[1]), pack2(v[2], v[3]));
      }
    } break;
    case EPI_RET_S: {
      const float* lg = (const float*)(ws + OFF_TAB);
      const float lgf = lg[b2], lgb = lg[4 + b2];
      float o[4];
#pragma unroll
      for (int j = 0; j < 4; ++j) {
        int d = m - (n + j);
        float arg = (d > 0) ? lgf * (float)d : lgb * (float)(-d);
        float f = (d == 0) ? 2.f : __expf(arg);
        o[j] = v[j] * f;
      }
      bf16_t* dst = (bf16_t*)g.C + b1 * g.sC1 + b2 * g.sC2 + (long)m * g.ldc + n;
      *(uint2*)dst = make_uint2(pack2(o[0], o[1]), pack2(o[2], o[3]));
    } break;
    case EPI_DIFF_IN: {
      const bool sample = m >= TP_;
      const int sb = (m - TP_) >> 10, ls = (m - TP_) & 1023;
      const int pb = m >> 8, lp = m & 255;
      if (n < 2048) {
        const bool isk = n >= 1024;
        const int c = n & 1023, h = c >> 7, d = c & 127;
        float x[4] = {v[0], v[1], v[2], v[3]};
        if (sample) {
          const int half = (d >> 5) & 1;
          const float pos = half ? (float)(ls & 63) : (float)(ls >> 6);
#pragma unroll
          for (int pp = 0; pp < 2; ++pp) {
            int i = ((d & 31) >> 1) + pp;
            float inv = __builtin_amdgcn_exp2f(-(float)i * (13.287712379549449f / 16.f));
            float ang = pos * inv;
            float cs = __cosf(ang), sn = __sinf(ang);
            float x1 = x[2 * pp], x2 = x[2 * pp + 1];
            x[2 * pp] = x1 * cs - x2 * sn;
            x[2 * pp + 1] = x1 * sn + x2 * cs;
          }
        }
        uint2 pk = make_uint2(pack2(x[0], x[1]), pack2(x[2], x[3]));
        if (!isk) {
          *(uint2*)((bf16_t*)(ws + L2_Q) + (long)m * 1024 + c) = pk;
        } else if (sample) {
          *(uint2*)((bf16_t*)(ws + L2_KALL) + ((long)(sb * 8 + h) * 1280 + ls) * 128 + d) = pk;
        } else {
          *(uint2*)((bf16_t*)(ws + L2_KP) + (long)m * 1024 + c) = pk;
          float* ck = p.out + OUT_DIFF_K + ((long)(pb * 8 + h) * 256 + lp) * 128 + (d & ~31) + ((d & 31) >> 1);
          *(float2*)ck = make_float2(v[0], v[2]);
          *(float2*)(ck + 16) = make_float2(v[1], v[3]);
        }
      } else if (n < 3072) {
        const int c = n - 2048, h = c >> 7, dv = c & 127;
        if (sample) {
          bf16_t* vt = (bf16_t*)(ws + L2_VTS) + ((long)(sb * 8 + h) * 128 + dv) * 1280 + ls;
#pragma unroll
          for (int j = 0; j < 4; ++j) vt[j * 1280] = f2bf(v[j]);
        } else {
          bf16_t* vt = (bf16_t*)(ws + L2_VTP) + ((long)(pb * 8 + h) * 128 + dv) * 256 + lp;
#pragma unroll
          for (int j = 0; j < 4; ++j) vt[j * 256] = f2bf(v[j]);
          nt_store4(p.out + OUT_DIFF_V + ((long)(pb * 8 + h) * 256 + lp) * 128 + dv, v[0], v[1], v[2], v[3]);
        }
      } else {
        *(uint2*)((bf16_t*)(ws + L2_G) + (long)m * 1024 + (n - 3072)) = make_uint2(pack2(v[0], v[1]), pack2(v[2], v[3]));
      }
    } break;
    case EPI_NA_IN: {
      const bool sample = m >= TP_;
      const int sb = (m - TP_) >> 10, ls = (m - TP_) & 1023;
      const int pb = m >> 8, lp = m & 255;
      uint2 pk = make_uint2(pack2(v[0], v[1]), pack2(v[2], v[3]));
      if (n < 1024) {
        *(uint2*)((bf16_t*)(ws + L2_Q) + (long)m * 1024 + n) = pk;
      } else if (n < 2048) {
        const int c = n - 1024, h = c >> 6, d = c & 63;
        if (sample) {
          *(uint2*)((bf16_t*)(ws + L2_KALL) + ((long)(sb * 16 + h) * 1280 + ls) * 64 + d) = pk;
        } else {
          *(uint2*)((bf16_t*)(ws + L2_KP) + (long)m * 1024 + c) = pk;
          nt_store4(p.out + OUT_NA_K + ((long)(pb * 16 + h) * 256 + lp) * 64 + d, v[0], v[1], v[2], v[3]);
        }
      } else if (n < 3072) {
        const int c = n - 2048, h = c >> 6, dv = c & 63;
        if (sample) {
          bf16_t* vt = (bf16_t*)(ws + L2_VTS) + ((long)(sb * 16 + h) * 64 + dv) * 1280 + ls;
#pragma unroll
          for (int j = 0; j < 4; ++j) vt[j * 1280] = f2bf(v[j]);
        } else {
          bf16_t* vt = (bf16_t*)(ws + L2_VTP) + ((long)(pb * 16 + h) * 64 + dv) * 256 + lp;
#pragma unroll
          for (int j = 0; j < 4; ++j) vt[j * 256] = f2bf(v[j]);
          nt_store4(p.out + OUT_NA_V + ((long)(pb * 16 + h) * 256 + lp) * 64 + dv, v[0], v[1], v[2], v[3]);
        }
      } else {
        *(uint2*)((bf16_t*)(ws + L2_G) + (long)m * 1024 + (n - 3072)) = pk;
      }
    } break;
  }
}

#define LDS_STRIDE 64
typedef __attribute__((address_space(3))) unsigned lds_u32;
template <int NT, int MI>
__device__ __forceinline__ void gemm_tile(const Params& p, const GemmDesc& g, int b1, int b2, int m0, int n0, char* smem) {
  constexpr int BN = NT * 32;
  constexpr int BM = MI * 32;
  bf16_t* As = (bf16_t*)smem;
  bf16_t* Bs = As + 2 * BM * LDS_STRIDE;
  const int tid = threadIdx.x, lane = tid & 63, wave = tid >> 6, wr = wave >> 1, wc = wave & 1, l15 = lane & 15, q4 = lane >> 4;
  const bf16_t* Ab = g.A + b1 * g.sA1 + b2 * g.sA2 + (long)m0 * g.lda;
  const bf16_t* Bb = g.B + b1 * g.sB1 + b2 * g.sB2 + (long)n0 * g.ldb;
  f32x4 acc[MI][NT];
#pragma unroll
  for (int i = 0; i < MI; ++i)
#pragma unroll
    for (int j = 0; j < NT; ++j) acc[i][j] = (f32x4){0.f, 0.f, 0.f, 0.f};
  const int nk = g.K >> 6;
  const int rsw = (l15 >> 1) & 7;
  const int prow = lane >> 3;
  const int gch = (lane & 7) ^ (((wave & 1) << 2) | (prow >> 1));
  const bf16_t* Ag = Ab + (long)(wave * 8 + prow) * g.lda + gch * 8;
  const bf16_t* Bg = Bb + (long)(wave * 8 + prow) * g.ldb + gch * 8;
  const long a32 = 32 * g.lda, b32 = 32 * g.ldb;
#define DMA(kt, buf)                                                                                         \
  {                                                                                                          \
    _Pragma("unroll") for (int i = 0; i < MI; ++i)                                                           \
      __builtin_amdgcn_global_load_lds((const unsigned*)(Ag + i * a32 + (kt) * 64),                          \
          (lds_u32*)((char*)As + (buf) * (BM * 128) + (i * 4 + wave) * 1024 + lane * 16), 16, 0, 0);         \
    _Pragma("unroll") for (int i = 0; i < NT / 1; ++i) if (i < BN / 32)                                      \
      __builtin_amdgcn_global_load_lds((const unsigned*)(Bg + i * b32 + (kt) * 64),                          \
          (lds_u32*)((char*)Bs + (buf) * (BN * 128) + (i * 4 + wave) * 1024 + lane * 16), 16, 0, 0);         \
  }
  bf16x8 af[2][MI], bfr[2][NT];
#define LOADFRAGS(buf)                                                                     \
  _Pragma("unroll") for (int ks = 0; ks < 2; ++ks) {                                       \
    _Pragma("unroll") for (int mi = 0; mi < MI; ++mi)                                      \
      af[ks][mi] = *(const bf16x8*)(As + ((buf) * BM + wr * (MI * 16) + mi * 16 + l15) * LDS_STRIDE + (((ks * 4 + q4) ^ rsw) << 3)); \
    _Pragma("unroll") for (int ni = 0; ni < NT; ++ni)                                      \
      bfr[ks][ni] = *(const bf16x8*)(Bs + ((buf) * BN + wc * (NT * 16) + ni * 16 + l15) * LDS_STRIDE + (((ks * 4 + q4) ^ rsw) << 3)); \
  }
#define COMPUTE()                                                                          \
  _Pragma("unroll") for (int ks = 0; ks < 2; ++ks)                                         \
    _Pragma("unroll") for (int mi = 0; mi < MI; ++mi)                                      \
      _Pragma("unroll") for (int ni = 0; ni < NT; ++ni)                                    \
        acc[mi][ni] = __builtin_amdgcn_mfma_f32_16x16x32_f16(bfr[ks][ni], af[ks][mi], acc[mi][ni], 0, 0, 0);
  DMA(0, 0)
  asm volatile("s_waitcnt vmcnt(0)" ::: "memory");
  __syncthreads();
  for (int kt = 0; kt < nk; ++kt) {
    const int buf = kt & 1;
    LOADFRAGS(buf)
    __builtin_amdgcn_sched_barrier(0);
    if (kt + 1 < nk) DMA(kt + 1, buf ^ 1)
    __builtin_amdgcn_sched_barrier(0);
    COMPUTE()
    __builtin_amdgcn_sched_barrier(0);
    asm volatile("s_waitcnt vmcnt(0)" ::: "memory");
    __syncthreads();
  }
#undef LOADFRAGS
#undef COMPUTE
#undef DMA
#pragma unroll
  for (int mi = 0; mi < MI; ++mi)
#pragma unroll
    for (int ni = 0; ni < NT; ++ni) {
      int m = m0 + wr * (MI * 16) + mi * 16 + l15;
      int n = n0 + wc * (NT * 16) + ni * 16 + q4 * 4;
      epilogue(p, g, b1, b2, m, n, acc[mi][ni]);
    }
}

__device__ __forceinline__ int desc_tiles(const GemmDesc& g) {
  int bn = g.bn64 ? 64 : 128;
  int bm = (g.flag & 256) ? 160 : 128;
  return g.nb1 * g.nb2 * (g.M / bm) * (g.N / bn);
}
__device__ __forceinline__ void run_desc_tile(const Params& p, const GemmDesc& g, int tile, char* smem) {
  int bn = g.bn64 ? 64 : 128;
  int bm = (g.flag & 256) ? 160 : 128;
  int tm = g.M / bm, tn = g.N / bn;
  int per = tm * tn;
  int batch = tile / per, rem = tile - batch * per;
  int nt = rem / tm, mt = rem - nt * tm;
  if (false && g.nb1 * g.nb2 == 1 && (tm & 7) == 0) {
    int snw = tn < 8 ? tn : 8;
    int sz = 8 * snw;
    int sup = rem / sz, within = rem - sup * sz;
    int nsm = tm >> 3;
    int sn = sup / nsm, sm_ = sup - sn * nsm;
    mt = sm_ * 8 + (within & 7);
    nt = sn * snw + (within >> 3);
  }
  int b1 = batch / g.nb2, b2 = batch - b1 * g.nb2;
  if (g.flag & 256) gemm_tile<4, 5>(p, g, b1, b2, mt * 160, nt * 128, smem);
  else if (g.bn64) gemm_tile<2, 4>(p, g, b1, b2, mt * 128, nt * 64, smem);
  else gemm_tile<4, 4>(p, g, b1, b2, mt * 128, nt * 128, smem);
}

__device__ __forceinline__ GemmDesc mkdesc(const void* A, long lda, const void* B, long ldb, int M, int N, int K, int epi) {
  GemmDesc g;
  g.A = (const bf16_t*)A; g.B = (const bf16_t*)B;
  g.lda = lda; g.ldb = ldb; g.M = M; g.N = N; g.K = K; g.nb1 = 1; g.nb2 = 1;
  g.sA1 = g.sA2 = g.sB1 = g.sB2 = 0; g.epi = epi; g.bn64 = 0; g.flag = 0; g.layer = 0;
  g.C = nullptr; g.ldc = 0; g.sC1 = g.sC2 = 0; g.scale = 1.f; g.aux = nullptr;
  return g;
}

__device__ __forceinline__ int get_descs(const Params& p, int gp, int idx, GemmDesc& g) {
  char* ws = p.ws;
  switch (gp) {
    case 0:
      g = mkdesc(ws + OFF_H, 1024, ws + OFF_WT_RET_IN, 1024, T_, 6144, 1024, EPI_RET_IN); g.flag = 256;
      return 1;
    case 1:
      if (idx == 0) {
        g = mkdesc(ws + L0_Q, 1024, ws + L0_K, 1024, 256, 256, 256, EPI_RET_S);
        g.nb1 = 32; g.nb2 = 4; g.sA1 = 256 * 1024; g.sA2 = 256; g.sB1 = 256 * 1024; g.sB2 = 256;
        g.C = (float*)(ws + L0_SP); g.ldc = 256; g.sC1 = 4 * 65536; g.sC2 = 65536;
      } else if (idx == 1) {
        g = mkdesc((bf16_t*)(ws + L0_Q) + (long)TP_ * 1024, 1024, (bf16_t*)(ws + L0_K) + (long)TP_ * 1024, 1024, 1024, 1024, 256, EPI_RET_S);
        g.nb1 = 2; g.nb2 = 4; g.sA1 = 1024 * 1024; g.sA2 = 256; g.sB1 = 1024 * 1024; g.sB2 = 256;
        g.C = (float*)(ws + L0_PEXT); g.ldc = 1536; g.sC1 = 4l * 1024 * 1536; g.sC2 = 1024l * 1536;
      } else {
        int dir = idx - 2;
        g = mkdesc((bf16_t*)(ws + L0_KT) + (long)dir * 32 * 4 * 65536, 256, ws + L0_VTP, 256, 256, 512, 256, EPI_F32);
        g.nb1 = 32; g.nb2 = 4; g.sA1 = 4 * 65536; g.sA2 = 65536; g.sB1 = 4 * 131072; g.sB2 = 131072;
        g.C = p.out + OUT_STATE_RET + (long)dir * 4 * 131072; g.ldc = 512; g.sC1 = 8 * 131072; g.sC2 = 131072; g.flag = 1;
      }
      return 4;
    case 2:
      if (idx == 1) {
        g = mkdesc(ws + L0_SP, 256, ws + L0_VTP, 256, 256, 512, 256, EPI_F32);
        g.nb1 = 32; g.nb2 = 4; g.sA1 = 4 * 65536; g.sA2 = 65536; g.sB1 = 4 * 131072; g.sB2 = 131072;
        g.C = (float*)(ws + L0_O); g.ldc = 2048; g.sC1 = 256 * 2048; g.sC2 = 512; g.flag = 2;
      } else {
        g = mkdesc(ws + L0_PEXT, 1536, ws + L0_VTS, 1536, 1024, 512, 1536, EPI_F32);
        g.nb1 = 2; g.nb2 = 4; g.sA1 = 4l * 1024 * 1536; g.sA2 = 1024l * 1536; g.sB1 = 4l * 512 * 1536; g.sB2 = 512l * 1536;
        g.C = (float*)((bf16_t*)(ws + L0_O) + (long)TP_ * 2048); g.ldc = 2048; g.sC1 = 1024 * 2048; g.sC2 = 512; g.flag = 2;
      }
      return 2;
    case 3:
      g = mkdesc(ws + OFF_OB, 2048, ws + OFF_WT_RET_OUT, 2048, T_, 1024, 2048, EPI_OUT); g.layer = 0; g.flag = 256;
      return 1;
    case 4: {
      if (idx < 4) {
        g = mkdesc(ws + L1_XM + (long)idx * 20 * MIB, 1024, (bf16_t*)(ws + OFF_WT_RWKV_IN) + (long)idx * 1024 * 1024, 1024, T_, 1024, 1024, EPI_BF16);
        g.C = (float*)((bf16_t*)(ws + L1_RKVG) + idx * 1024); g.ldc = 4096;
      } else {
        int w = idx - 4;
        g = mkdesc(ws + L1_XW + (long)w * 20 * MIB, 1024, (bf16_t*)(ws + OFF_WT_LDOWN) + (long)w * 128 * 1024, 1024, T_, 128, 1024, EPI_BF16);
        g.C = (float*)((bf16_t*)(ws + L1_L) + w * 128); g.ldc = 256; g.flag = (w == 0) ? 1 : 0;
      }
      return 6;
    }
    case 5: {
      int dir = idx >> 1, type = idx & 1;
      g = mkdesc((bf16_t*)(ws + L1_L) + type * 128 + dir * 64, 256, (bf16_t*)(ws + OFF_WT_LUP) + (long)(type * 2 + dir) * 65536, 64, T_, 1024, 64,
                 type ? EPI_LUP_A : EPI_LUP_W);
      g.C = (float*)((bf16_t*)(ws + (type ? L1_AA : L1_DEC)) + (long)dir * T_ * 1024);
      g.aux = (type ? p.in[23] : p.in[20]) + dir * 1024;
      return 4;
    }
    case 6:
      g = mkdesc(ws + OFF_OB, 1024, ws + OFF_WT_RWKV_OUT, 1024, T_, 1024, 1024, EPI_OUT); g.layer = 1; g.flag = 256;
      return 1;
    case 7:
      g = mkdesc(ws + OFF_H, 1024, ws + OFF_WT_DIFF_IN, 1024, T_, 4096, 1024, EPI_DIFF_IN); g.flag = 256;
      return 1;
    case 10:
      g = mkdesc(ws + OFF_OB, 1024, ws + OFF_WT_DIFF_OUT, 1024, T_, 1024, 1024, EPI_OUT); g.layer = 2; g.flag = 256;
      return 1;
    case 11:
      g = mkdesc(ws + OFF_H, 1024, ws + OFF_WT_NA_IN, 1024, T_, 4096, 1024, EPI_NA_IN); g.flag = 256;
      return 1;
    case 14:
      g = mkdesc(ws + OFF_OB, 1024, ws + OFF_WT_NA_OUT, 1024, T_, 1024, 1024, EPI_OUT); g.layer = 3; g.flag = 256;
      return 1;
  }
  return 0;
}

__device__ __forceinline__ void gemm_phase(const Params& p, int gp, char* smem, int vb) {
  GemmDesc g;
  int nd = get_descs(p, gp, 0, g);
  int base = 0;
  int tile = vb;
  for (int d = 0; d < nd; ++d) {
    if (d > 0) get_descs(p, gp, d, g);
    int nt = desc_tiles(g);
    while (tile < base + nt) {
      run_desc_tile(p, g, tile - base, smem);
      tile += gridDim.x;
    }
    base += nt;
  }
}

struct TJob { const float* src; int K, N; bf16_t* dst; int perm; };
__device__ __forceinline__ TJob tjob(const Params& p, int j) {
  char* ws = p.ws;
  TJob t; t.perm = 0;
  switch (j) {
    case 0: t.src = p.in[14]; t.K = 1024; t.N = 6144; t.dst = (bf16_t*)(ws + OFF_WT_RET_IN); t.perm = 1; break;
    case 1: t.src = p.in[17]; t.K = 2048; t.N = 1024; t.dst = (bf16_t*)(ws + OFF_WT_RET_OUT); break;
    case 2: t.src = p.in[19]; t.K = 1024; t.N = 4096; t.dst = (bf16_t*)(ws + OFF_WT_RWKV_IN); break;
    case 3: t.src = p.in[30]; t.K = 1024; t.N = 1024; t.dst = (bf16_t*)(ws + OFF_WT_RWKV_OUT); break;
    case 4: t.src = p.in[31]; t.K = 1024; t.N = 4096; t.dst = (bf16_t*)(ws + OFF_WT_DIFF_IN); t.perm = 2; break;
    case 5: t.src = p.in[34]; t.K = 1024; t.N = 1024; t.dst = (bf16_t*)(ws + OFF_WT_DIFF_OUT); break;
    case 6: t.src = p.in[35]; t.K = 1024; t.N = 4096; t.dst = (bf16_t*)(ws + OFF_WT_NA_IN); break;
    case 7: t.src = p.in[37]; t.K = 1024; t.N = 1024; t.dst = (bf16_t*)(ws + OFF_WT_NA_OUT); break;
    case 8: case 9: t.src = p.in[21] + (j - 8) * 65536; t.K = 1024; t.N = 64; t.dst = (bf16_t*)(ws + OFF_WT_LDOWN) + (long)(j - 8) * 64 * 1024; break;
    case 10: case 11: t.src = p.in[24] + (j - 10) * 65536; t.K = 1024; t.N = 64; t.dst = (bf16_t*)(ws + OFF_WT_LDOWN) + (long)(128 + (j - 10) * 64) * 1024; break;
    case 12: case 13: t.src = p.in[22] + (j - 12) * 65536; t.K = 64; t.N = 1024; t.dst = (bf16_t*)(ws + OFF_WT_LUP) + (long)(j - 12) * 65536; break;
    default: t.src = p.in[25] + (j - 14) * 65536; t.K = 64; t.N = 1024; t.dst = (bf16_t*)(ws + OFF_WT_LUP) + (long)(2 + j - 14) * 65536; break;
  }
  return t;
}

__device__ __forceinline__ void transpose_tile(const TJob& t, int tile, char* smem) {
  float* sm = (float*)smem;
  const int tid = threadIdx.x;
  int tn = t.N >> 6;
  int kt = tile / tn, nt = tile - kt * tn;
  int k0 = kt * 64, n0 = nt * 64;
  __syncthreads();
#pragma unroll
  for (int it = 0; it < 16; ++it) {
    int kk = it * 4 + (tid >> 6), nn = tid & 63;
    int nd = n0 + nn;
    int ns = nd;
    if (t.perm == 1 && nd < 2048) ns = (nd & ~255) + perm_ret(nd & 255);
    else if (t.perm == 2 && nd < 2048) ns = perm_diff(nd);
    sm[kk * 65 + nn] = __builtin_nontemporal_load(t.src + (long)(k0 + kk) * t.N + ns);
  }
  __syncthreads();
#pragma unroll
  for (int it = 0; it < 2; ++it) {
    int gidx = tid + it * 256;
    int n = gidx >> 3, kg = gidx & 7;
    unsigned w[4];
#pragma unroll
    for (int e = 0; e < 4; ++e) w[e] = pack2(sm[(kg * 8 + 2 * e) * 65 + n], sm[(kg * 8 + 2 * e + 1) * 65 + n]);
    *(uint4*)(t.dst + (long)(n0 + n) * t.K + k0 + kg * 8) = make_uint4(w[0], w[1], w[2], w[3]);
  }
}

__device__ __forceinline__ void transposes_subset(const Params& p, char* smem, unsigned mask, int worker, int nworkers) {
  int base = 0, tile = worker;
  for (int j = 0; j < 16; ++j) {
    if (!((mask >> j) & 1u)) continue;
    TJob t = tjob(p, j);
    int nt = (t.K >> 6) * (t.N >> 6);
    while (tile < base + nt) { transpose_tile(t, tile - base, smem); tile += nworkers; }
    base += nt;
  }
  __syncthreads();
}
__device__ __forceinline__ void mod_gemv_items(const Params& p, char* smem, int item_lo, int item_hi, int worker, int nworkers) {
  char* ws = p.ws;
  const int tid = threadIdx.x;

    float* sm = (float*)smem;
    const float* wmod = p.in[11];
    const float* bmod = p.in[12];
    for (int item = item_lo + worker; item < item_hi; item += nworkers) {
      int layer = item / 192, cg16 = item - layer * 192;
      int j0 = cg16 * 16;
      int c4 = tid & 3, r = tid >> 2;
      float acc[3][4];
#pragma unroll
      for (int c = 0; c < 3; ++c)
#pragma unroll
        for (int e = 0; e < 4; ++e) acc[c][e] = 0.f;
      float4 wr[16];
#pragma unroll
      for (int it = 0; it < 16; ++it)
        {
          f32x4 t4 = __builtin_nontemporal_load((const f32x4*)(wmod + ((long)layer * 1024 + r + it * 64) * 3072 + j0 + c4 * 4));
          wr[it] = make_float4(t4[0], t4[1], t4[2], t4[3]);
        }
#pragma unroll
      for (int it = 0; it < 16; ++it) {
        int row = r + it * 64;
        float4 w = wr[it];
        float cv0 = p.in[9][row], cv1 = p.in[8][row], cv2 = p.in[8][1024 + row];
        float s0 = silu_f(cv0), s1 = silu_f(cv1), s2 = silu_f(cv2);
        acc[0][0] += s0 * w.x; acc[0][1] += s0 * w.y; acc[0][2] += s0 * w.z; acc[0][3] += s0 * w.w;
        acc[1][0] += s1 * w.x; acc[1][1] += s1 * w.y; acc[1][2] += s1 * w.z; acc[1][3] += s1 * w.w;
        acc[2][0] += s2 * w.x; acc[2][1] += s2 * w.y; acc[2][2] += s2 * w.z; acc[2][3] += s2 * w.w;
      }
      __syncthreads();
#pragma unroll
      for (int c = 0; c < 3; ++c)
#pragma unroll
        for (int e = 0; e < 4; ++e) sm[tid * 12 + c * 4 + e] = acc[c][e];
      __syncthreads();
      if (tid < 48) {
        int c = tid / 16, col = tid & 15;
        int cc4 = col >> 2, e = col & 3;
        float s = 0.f;
        for (int rr = 0; rr < 64; ++rr) s += sm[(rr * 4 + cc4) * 12 + c * 4 + e];
        ((float*)(ws + OFF_MOD))[((long)layer * 3 + c) * 3072 + j0 + col] = s + bmod[layer * 3072 + j0 + col];
      }
    }
    __syncthreads();
}

__device__ __forceinline__ void prep_phase(const Params& p, char* smem) {
  char* ws = p.ws;
  const int tid = threadIdx.x;
  transposes_subset(p, smem, (gridDim.x == 512) ? 0x0001u : 0xFFFFu, blockIdx.x, gridDim.x);
  __syncthreads();
  mod_gemv_items(p, smem, 0, (gridDim.x == 512) ? 192 : 768, blockIdx.x, gridDim.x);
  const long gtid = (long)blockIdx.x * 256 + tid;
  const long gn = (long)gridDim.x * 256;
  if (gtid < 8) {
    float x = p.in[15][gtid];
    float u = -x;
    ((float*)(ws + OFF_TAB))[gtid] = -(fmaxf(u, 0.f) + log1pf(expf(-fabsf(u))));
  }
  for (long i = gtid; i < 2l * 4 * 512 * 512; i += gn) {
    int col = i & 511; long r = i >> 9; int dv = r & 511; r >>= 9; int h = r & 3; int sb = r >> 2;
    int dir = col >> 8, dkp = col & 255;
    float v = p.in[2][((((long)sb * 2 + dir) * 4 + h) * 256 + perm_ret(dkp)) * 512 + dv];
    ((bf16_t*)(ws + L0_VTS))[((long)(sb * 4 + h) * 512 + dv) * 1536 + 1024 + col] = f2bf(v);
  }
}

__device__ __forceinline__ void diff_cache_prep(const Params& p) {
  char* ws = p.ws;
  const long gtid = (long)blockIdx.x * 256 + threadIdx.x;
  const long gn = (long)gridDim.x * 256;
  for (long i = gtid; i < 2l * 8 * 256 * 128; i += gn) {
    int d = i & 127; long r = i >> 7; int pp = r & 255; r >>= 8; int h = r & 7; int sb = r >> 3;
    float kv = p.in[4][((long)(sb * 8 + h) * 256 + pp) * 128 + perm_diff(d)];
    ((bf16_t*)(ws + L2_KALL))[((long)(sb * 8 + h) * 1280 + 1024 + pp) * 128 + d] = f2bf(kv);
  }
  for (long i = gtid; i < 2l * 8 * 128 * 256; i += gn) {
    int pp = i & 255; long r = i >> 8; int dv = r & 127; r >>= 7; int h = r & 7; int sb = r >> 3;
    float vv = p.in[5][((long)(sb * 8 + h) * 256 + pp) * 128 + dv];
    ((bf16_t*)(ws + L2_VTS))[((long)(sb * 8 + h) * 128 + dv) * 1280 + 1024 + pp] = f2bf(vv);
  }
}

__device__ __forceinline__ void na_cache_prep(const Params& p) {
  char* ws = p.ws;
  const long gtid = (long)blockIdx.x * 256 + threadIdx.x;
  const long gn = (long)gridDim.x * 256;
  for (long i = gtid; i < 2l * 16 * 256 * 64; i += gn) {
    int d = i & 63; long r = i >> 6; int pp = r & 255; r >>= 8; int h = r & 15; int sb = r >> 4;
    float kv = p.in[6][((long)(sb * 16 + h) * 256 + pp) * 64 + d];
    ((bf16_t*)(ws + L2_KALL))[((long)(sb * 16 + h) * 1280 + 1024 + pp) * 64 + d] = f2bf(kv);
  }
  for (long i = gtid; i < 2l * 16 * 64 * 256; i += gn) {
    int pp = i & 255; long r = i >> 8; int dv = r & 63; r >>= 6; int h = r & 15; int sb = r >> 4;
    float vv = p.in[7][((long)(sb * 16 + h) * 256 + pp) * 64 + dv];
    ((bf16_t*)(ws + L2_VTS))[((long)(sb * 16 + h) * 64 + dv) * 1280 + 1024 + pp] = f2bf(vv);
  }
}

__device__ __forceinline__ const float* xrow(const Params& p, int layer, int t) {
  if (layer == 0) return (t < TP_) ? p.in[0] + (long)t * 1024 : p.in[1] + (long)(t - TP_) * 1024;
  return p.out + (long)t * 1024;
}
struct F16 { float4 v[4]; };
__device__ __forceinline__ F16 norm_row(const Params& p, int layer, int t, int lane) {
  const float* x = xrow(p, layer, t);
  F16 h;
  float ss = 0.f;
#pragma unroll
  for (int it = 0; it < 4; ++it) {
    float4 v = *(const float4*)(x + it * 256 + lane * 4);
    h.v[it] = v;
    ss += v.x * v.x + v.y * v.y + v.z * v.z + v.w * v.w;
  }
  ss = wave_sum(ss);
  float rinv = rsqrtf(ss * (1.f / 1024.f) + 1e-6f);
  int cond = (t < TP_) ? 0 : 1 + ((t - TP_) >> 10);
  const float* mod = (const float*)(p.ws + OFF_MOD) + ((long)layer * 3 + cond) * 3072;
  const float* nw = p.in[10] + layer * 1024;
#pragma unroll
  for (int it = 0; it < 4; ++it) {
    int c = it * 256 + lane * 4;
    float4 w = *(const float4*)(nw + c);
    float4 sh = *(const float4*)(mod + c);
    float4 sc = *(const float4*)(mod + 1024 + c);
    h.v[it].x = h.v[it].x * rinv * w.x * (1.f + sc.x) + sh.x;
    h.v[it].y = h.v[it].y * rinv * w.y * (1.f + sc.y) + sh.y;
    h.v[it].z = h.v[it].z * rinv * w.z * (1.f + sc.z) + sh.z;
    h.v[it].w = h.v[it].w * rinv * w.w * (1.f + sc.w) + sh.w;
  }
  return h;
}
__device__ __forceinline__ void norm_phase(const Params& p, int layer) {
  const int lane = threadIdx.x & 63;
  const int gw = blockIdx.x * 4 + (threadIdx.x >> 6), nw = gridDim.x * 4;
  bf16_t* H = (bf16_t*)(p.ws + OFF_H);
  if (layer != 1) {
    for (int t = gw; t < T_; t += nw) {
      F16 h = norm_row(p, layer, t, lane);
#pragma unroll
      for (int it = 0; it < 4; ++it)
        *(uint2*)(H + (long)t * 1024 + it * 256 + lane * 4) = make_uint2(pack2(h.v[it].x, h.v[it].y), pack2(h.v[it].z, h.v[it].w));
    }
  } else {
    const float* mu = p.in[18];
    for (int chunk = gw; chunk < T_ / 4; chunk += nw) {
      const int t0 = chunk * 4;
      const int L = (t0 < TP_) ? 256 : 1024;
      const int l0 = (t0 < TP_) ? (t0 & 255) : ((t0 - TP_) & 1023);
      const bool hasp = l0 > 0, hasn = (l0 + 4 < L);
      float rinv[6];
#pragma unroll
      for (int j = 0; j < 6; ++j) {
        const bool ok = (j == 0) ? hasp : ((j == 5) ? hasn : true);
        const float* x = xrow(p, layer, ok ? (t0 - 1 + j) : t0);
        float ss = 0.f;
#pragma unroll
        for (int it = 0; it < 4; ++it) {
          const float4 v = *(const float4*)(x + it * 256 + lane * 4);
          ss += v.x * v.x + v.y * v.y + v.z * v.z + v.w * v.w;
        }
        rinv[j] = ok ? rsqrtf(wave_sum(ss) * (1.f / 1024.f) + 1e-6f) : 0.f;
      }
      const int cond = (t0 < TP_) ? 0 : 1 + ((t0 - TP_) >> 10);
      const float* mod = (const float*)(p.ws + OFF_MOD) + ((long)layer * 3 + cond) * 3072;
      const float* nwp = p.in[10] + layer * 1024;
#pragma unroll
      for (int it = 0; it < 4; ++it) {
        const int c = it * 256 + lane * 4;
        const float4 w = *(const float4*)(nwp + c);
        const float4 sh = *(const float4*)(mod + c);
        const float4 sc = *(const float4*)(mod + 1024 + c);
        const float4 ws4 = make_float4(w.x * (1.f + sc.x), w.y * (1.f + sc.y), w.z * (1.f + sc.z), w.w * (1.f + sc.w));
        float4 hr0, hr1, hr2, hr3, hr4, hr5;
#define NROW(dst, j)                                                                            \
        {                                                                                       \
          const bool ok = ((j) == 0) ? hasp : (((j) == 5) ? hasn : true);                        \
          const float4 v = *(const float4*)(xrow(p, layer, ok ? (t0 - 1 + (j)) : t0) + c);       \
          const float ri = rinv[j];                                                              \
          dst = ok ? make_float4(v.x * ri * ws4.x + sh.x, v.y * ri * ws4.y + sh.y, v.z * ri * ws4.z + sh.z, v.w * ri * ws4.w + sh.w) \
                   : make_float4(0.f, 0.f, 0.f, 0.f);                                            \
        }
        NROW(hr0, 0) NROW(hr1, 1) NROW(hr2, 2) NROW(hr3, 3) NROW(hr4, 4) NROW(hr5, 5)
#undef NROW
#define MIX1(ha, hh, hb, j)                                                                      \
          {                                                                                      \
            float x0 = hh.x + (0.5f * (ha.x + hb.x) - hh.x) * m.x;                               \
            float x1 = hh.y + (0.5f * (ha.y + hb.y) - hh.y) * m.y;                               \
            float x2 = hh.z + (0.5f * (ha.z + hb.z) - hh.z) * m.z;                               \
            float x3 = hh.w + (0.5f * (ha.w + hb.w) - hh.w) * m.w;                               \
            *(uint2*)(dst + (long)(t0 + (j)) * 1024 + c) = make_uint2(pack2(x0, x1), pack2(x2, x3)); \
          }
#pragma unroll
        for (int n = 0; n < 6; ++n) {
          bf16_t* dst = (n == 0) ? (bf16_t*)(p.ws + L1_XM) : (n == 2) ? (bf16_t*)(p.ws + L1_XM + 20 * MIB) : (n == 3) ? (bf16_t*)(p.ws + L1_XM + 40 * MIB)
                      : (n == 5) ? (bf16_t*)(p.ws + L1_XM + 60 * MIB) : (n == 1) ? (bf16_t*)(p.ws + L1_XW) : (bf16_t*)(p.ws + L1_XW + 20 * MIB);
          const float4 m = *(const float4*)(mu + n * 1024 + c);
          MIX1(hr0, hr1, hr2, 0)
          MIX1(hr1, hr2, hr3, 1)
          MIX1(hr2, hr3, hr4, 2)
          MIX1(hr3, hr4, hr5, 3)
        }
#undef MIX1
      }
    }
  }
}

__device__ __forceinline__ void final_norm_phase(const Params& p) {
  const int lane = threadIdx.x & 63;
  const int gw = blockIdx.x * 4 + (threadIdx.x >> 6), nw = gridDim.x * 4;
  const float* fw = p.in[13];
  for (int t = gw; t < T_; t += nw) {
    float* x = p.out + (long)t * 1024;
    float4 v[4];
    float ss = 0.f;
#pragma unroll
    for (int it = 0; it < 4; ++it) {
      v[it] = *(const float4*)(x + it * 256 + lane * 4);
      ss += v[it].x * v[it].x + v[it].y * v[it].y + v[it].z * v[it].z + v[it].w * v[it].w;
    }
    ss = wave_sum(ss);
    float rinv = rsqrtf(ss * (1.f / 1024.f) + 1e-6f);
#pragma unroll
    for (int it = 0; it < 4; ++it) {
      float4 w = *(const float4*)(fw + it * 256 + lane * 4);
      *(float4*)(x + it * 256 + lane * 4) = make_float4(v[it].x * rinv * w.x, v[it].y * rinv * w.y, v[it].z * rinv * w.z, v[it].w * rinv * w.w);
    }
  }
}

__device__ __forceinline__ void ret_ln_phase(const Params& p) {
  const int lane = threadIdx.x & 63;
  const int gw = blockIdx.x * 4 + (threadIdx.x >> 6), nw = gridDim.x * 4;
  const bf16_t* O = (const bf16_t*)(p.ws + L0_O);
  const bf16_t* G = (const bf16_t*)(p.ws + L0_G);
  bf16_t* OB = (bf16_t*)(p.ws + OFF_OB);
  const float* gn = p.in[16];
  for (int item = gw; item < T_ * 4; item += nw) {
    long base = (long)item * 512 + lane * 8;
    const uint4 oh = *(const uint4*)(O + base);
    float4 a = make_float4(bf2f(oh.x & 0xffff), bf2f(oh.x >> 16), bf2f(oh.y & 0xffff), bf2f(oh.y >> 16));
    float4 b = make_float4(bf2f(oh.z & 0xffff), bf2f(oh.z >> 16), bf2f(oh.w & 0xffff), bf2f(oh.w >> 16));
    float s = a.x + a.y + a.z + a.w + b.x + b.y + b.z + b.w;
    float mean = wave_sum(s) * (1.f / 512.f);
    a.x -= mean; a.y -= mean; a.z -= mean; a.w -= mean; b.x -= mean; b.y -= mean; b.z -= mean; b.w -= mean;
    float vs = a.x * a.x + a.y * a.y + a.z * a.z + a.w * a.w + b.x * b.x + b.y * b.y + b.z * b.z + b.w * b.w;
    float rinv = rsqrtf(wave_sum(vs) * (1.f / 512.f) + 1e-5f);
    int col = (item & 3) * 512 + lane * 8;
    uint4 gg = *(const uint4*)(G + base);
    float4 w0 = *(const float4*)(gn + col), w1 = *(const float4*)(gn + col + 4);
    uint4 o;
    o.x = pack2(a.x * rinv * w0.x * silu_f(bf2f(gg.x & 0xffff)), a.y * rinv * w0.y * silu_f(bf2f(gg.x >> 16)));
    o.y = pack2(a.z * rinv * w0.z * silu_f(bf2f(gg.y & 0xffff)), a.w * rinv * w0.w * silu_f(bf2f(gg.y >> 16)));
    o.z = pack2(b.x * rinv * w1.x * silu_f(bf2f(gg.z & 0xffff)), b.y * rinv * w1.y * silu_f(bf2f(gg.z >> 16)));
    o.w = pack2(b.z * rinv * w1.z * silu_f(bf2f(gg.w & 0xffff)), b.w * rinv * w1.w * silu_f(bf2f(gg.w >> 16)));
    *(uint4*)(OB + base) = o;
  }
}

__device__ __forceinline__ float dpp_xor1(float x) {
  return __builtin_bit_cast(float, __builtin_amdgcn_mov_dpp(__builtin_bit_cast(int, x), 0xB1, 0xF, 0xF, true));
}
__device__ __forceinline__ float dpp_xor2(float x) {
  return __builtin_bit_cast(float, __builtin_amdgcn_mov_dpp(__builtin_bit_cast(int, x), 0x4E, 0xF, 0xF, true));
}
__device__ __forceinline__ float dpp_hmirror(float x) {
  return __builtin_bit_cast(float, __builtin_amdgcn_mov_dpp(__builtin_bit_cast(int, x), 0x141, 0xF, 0xF, true));
}
__device__ __forceinline__ float red8(float x) {
  x += dpp_xor1(x);
  x += dpp_xor2(x);
  x += dpp_hmirror(x);
  return x;
}
template <int R>
__device__ __forceinline__ void rwkv_scan_item(const Params& p, int sample, int bb, int h, int dir, int half, char* smem) {
  char* ws = p.ws;
  float* sm = (float*)smem;
  const int tid = threadIdx.x;
  int L = sample ? 1024 : 256;
  int tok0 = sample ? TP_ + bb * 1024 : bb * 256;
  const int rp = tid >> 3, kq = tid & 7;
  const int row0 = (R == 2) ? 2 * rp : half * 32 + rp;
  v2f P[8];
#pragma unroll
  for (int i = 0; i < 8; ++i) P[i] = (v2f)(0.f);
  if (sample) {
    const float* s0 = p.in[3] + (((long)(bb * 2 + dir) * 16 + h) * 64 + row0) * 64 + kq * 8;
    if (R == 2) {
#pragma unroll
      for (int i = 0; i < 8; ++i) { P[i].x = s0[i]; P[i].y = s0[64 + i]; }
    } else {
#pragma unroll
      for (int j = 0; j < 4; ++j) { P[j].x = s0[2 * j]; P[j].y = s0[2 * j + 1]; }
    }
  }
  const bf16_t* RKVG = (const bf16_t*)(ws + L1_RKVG);
  const bf16_t* DEC = (const bf16_t*)(ws + L1_DEC) + (long)dir * T_ * 1024;
  const bf16_t* AA = (const bf16_t*)(ws + L1_AA) + (long)dir * T_ * 1024;
  float* Y = (float*)(ws + L1_Y) + (long)dir * T_ * 1024;
  const int ch = tid & 63, col = h * 64 + ch, sw = tid >> 6;
  const float kkw = p.in[26][col];
  const float kaw = p.in[27][col];
  const int nch = L >> 4;
  float rr[4], rk[4], rv[4], rwd[4], ra[4];
#define SCAN_LOAD(c)                                                        \
  _Pragma("unroll") for (int i = 0; i < 4; ++i) {                           \
    int pos = (c) * 16 + sw + i * 4;                                        \
    int t = dir ? (L - 1 - pos) : pos;                                      \
    long tok = tok0 + t;                                                    \
    rr[i] = bf2f(RKVG[tok * 4096 + col]);                                   \
    rk[i] = bf2f(RKVG[tok * 4096 + 1024 + col]);                            \
    rv[i] = bf2f(RKVG[tok * 4096 + 2048 + col]);                            \
    rwd[i] = __expf(-bf2f(DEC[tok * 1024 + col]));                          \
    ra[i] = bf2f(AA[tok * 1024 + col]);                                     \
  }
#define SCAN_PREP(buf)                                                      \
  _Pragma("unroll") for (int i = 0; i < 4; ++i) {                           \
    float* b = sm + (buf) * 6144 + (sw + i * 4) * 64 + ch;                  \
    float kkr = rk[i] * kkw;                                                \
    float ss = wave_sum(kkr * kkr);                                         \
    float kk = kkr * rsqrtf(fmaxf(ss, 1e-12f));                             \
    b[0] = rr[i]; b[1024] = rwd[i]; b[2048] = kk; b[3072] = kk * ra[i];     \
    b[4096] = rk[i] * (1.f + (ra[i] - 1.f) * kaw); b[5120] = rv[i];         \
  }
#define YFLUSH(cc)                                                                   \
  {                                                                                  \
    constexpr int QPR = (R == 2) ? 16 : 8;                     \
    if (tid < 16 * QPR) {                                                            \
      const int s_ = tid / QPR, q_ = tid - s_ * QPR;                                 \
      const int pos_ = (cc) * 16 + s_;                                               \
      const int t_ = dir ? (L - 1 - pos_) : pos_;                                    \
      const float4 yv = *(const float4*)(sm + 12288 + ((cc) & 1) * 1024 + s_ * 64 + q_ * 4); \
      *(float4*)(Y + (long)(tok0 + t_) * 1024 + h * 64 + ((R == 2) ? 0 : half * 32) + q_ * 4) = yv; \
    }                                                                                \
  }
  __syncthreads();
  SCAN_LOAD(0)
  SCAN_PREP(0)
  for (int c = 0; c < nch; ++c) {
    const int buf = c & 1;
    if (c + 1 < nch) SCAN_LOAD(c + 1)
    __syncthreads();
    if (c > 0) YFLUSH(c - 1)
    const float* bs = sm + buf * 6144;
    float4 n_kk0, n_kk1, n_w0, n_w1, n_ka0, n_ka1, n_kd0, n_kd1, n_r0, n_r1; float n_vx, n_vy = 0.f;
#define STEP_LOAD(s)                                                              \
    {                                                                             \
      const float* o = bs + (s) * 64 + kq * 8;                                    \
      n_kk0 = *(const float4*)(o + 2048); n_kk1 = *(const float4*)(o + 2052);     \
      n_w0 = *(const float4*)(o + 1024); n_w1 = *(const float4*)(o + 1028);       \
      n_ka0 = *(const float4*)(o + 3072); n_ka1 = *(const float4*)(o + 3076);     \
      n_kd0 = *(const float4*)(o + 4096); n_kd1 = *(const float4*)(o + 4100);     \
      n_r0 = *(const float4*)(o); n_r1 = *(const float4*)(o + 4);                 \
      if (R == 2) { const float2 vv = *(const float2*)(bs + 5120 + (s) * 64 + row0); n_vx = vv.x; n_vy = vv.y; } \
      else n_vx = bs[5120 + (s) * 64 + row0];                                     \
    }
    STEP_LOAD(0)
#pragma unroll
    for (int s = 0; s < 16; ++s) {
      const float4 kka = n_kk0, kkb = n_kk1, wa = n_w0, wb = n_w1, ka = n_ka0, kb = n_ka1, da = n_kd0, db = n_kd1, ra4 = n_r0, rb4 = n_r1;
      const float vx = n_vx, vy = n_vy;
      if (s + 1 < 16) STEP_LOAD(s + 1)
      const float kkv[8] = {kka.x, kka.y, kka.z, kka.w, kkb.x, kkb.y, kkb.z, kkb.w};
      const float wv[8] = {wa.x, wa.y, wa.z, wa.w, wb.x, wb.y, wb.z, wb.w};
      const float kv[8] = {ka.x, ka.y, ka.z, ka.w, kb.x, kb.y, kb.z, kb.w};
      const float dv[8] = {da.x, da.y, da.z, da.w, db.x, db.y, db.z, db.w};
      const float rv8[8] = {ra4.x, ra4.y, ra4.z, ra4.w, rb4.x, rb4.y, rb4.z, rb4.w};
      float y0, y1 = 0.f;
      if (R == 2) {
        v2f dA = P[0] * (v2f)(kkv[0]), dB = P[1] * (v2f)(kkv[1]);
#pragma unroll
        for (int i = 2; i < 8; i += 2) { dA += P[i] * (v2f)(kkv[i]); dB += P[i + 1] * (v2f)(kkv[i + 1]); }
        const v2f d = dA + dB;
        v2f sa; sa.x = -red8(d.x); sa.y = -red8(d.y);
        v2f vv; vv.x = vx; vv.y = vy;
        v2f yA = (v2f)(0.f), yB = (v2f)(0.f);
#pragma unroll
        for (int i = 0; i < 8; i += 2) {
          P[i] = P[i] * (v2f)(wv[i]) + (sa * (v2f)(kv[i]) + vv * (v2f)(dv[i]));
          P[i + 1] = P[i + 1] * (v2f)(wv[i + 1]) + (sa * (v2f)(kv[i + 1]) + vv * (v2f)(dv[i + 1]));
          yA += P[i] * (v2f)(rv8[i]); yB += P[i + 1] * (v2f)(rv8[i + 1]);
        }
        const v2f yy = yA + yB;
        y0 = red8(yy.x); y1 = red8(yy.y);
      } else {
        v2f dA = P[0] * (v2f){kkv[0], kkv[1]} + P[2] * (v2f){kkv[4], kkv[5]};
        v2f dB = P[1] * (v2f){kkv[2], kkv[3]} + P[3] * (v2f){kkv[6], kkv[7]};
        const v2f d = dA + dB;
        const float sa = -red8(d.x + d.y);
        v2f yA = (v2f)(0.f), yB = (v2f)(0.f);
#pragma unroll
        for (int j = 0; j < 4; j += 2) {
          P[j] = P[j] * (v2f){wv[2 * j], wv[2 * j + 1]} + ((v2f)(sa) * (v2f){kv[2 * j], kv[2 * j + 1]} + (v2f)(vx) * (v2f){dv[2 * j], dv[2 * j + 1]});
          P[j + 1] = P[j + 1] * (v2f){wv[2 * j + 2], wv[2 * j + 3]} + ((v2f)(sa) * (v2f){kv[2 * j + 2], kv[2 * j + 3]} + (v2f)(vx) * (v2f){dv[2 * j + 2], dv[2 * j + 3]});
          yA += P[j] * (v2f){rv8[2 * j], rv8[2 * j + 1]}; yB += P[j + 1] * (v2f){rv8[2 * j + 2], rv8[2 * j + 3]};
        }
        const v2f yy = yA + yB;
        y0 = red8(yy.x + yy.y);
      }
      if (kq == 0) {
        float* yb = sm + 12288 + buf * 1024 + s * 64 + ((R == 2) ? 2 * rp : rp);
        if (R == 2) *(float2*)yb = make_float2(y0, y1);
        else *yb = y0;
      }
    }
#undef STEP_LOAD
    if (c + 1 < nch) SCAN_PREP(buf ^ 1)
  }
  __syncthreads();
  YFLUSH(nch - 1)
#undef YFLUSH
#undef SCAN_LOAD
#undef SCAN_PREP
  if (!sample) {
    float* so = p.out + OUT_STATE_RWKV + (((long)(bb * 2 + dir) * 16 + h) * 64 + row0) * 64 + kq * 8;
    if (R == 2) {
      *(float4*)(so) = make_float4(P[0].x, P[1].x, P[2].x, P[3].x);
      *(float4*)(so + 4) = make_float4(P[4].x, P[5].x, P[6].x, P[7].x);
      *(float4*)(so + 64) = make_float4(P[0].y, P[1].y, P[2].y, P[3].y);
      *(float4*)(so + 68) = make_float4(P[4].y, P[5].y, P[6].y, P[7].y);
    } else {
      *(float4*)(so) = make_float4(P[0].x, P[0].y, P[1].x, P[1].y);
      *(float4*)(so + 4) = make_float4(P[2].x, P[2].y, P[3].x, P[3].y);
    }
  }
}
__device__ __forceinline__ void deferred_transposes(const Params& p, char* smem, int worker, int nworkers) {
  int base = 0, tile = worker;
  for (int j = 4; j <= 7; ++j) {
    TJob t = tjob(p, j);
    int nt = (t.K >> 6) * (t.N >> 6);
    while (tile < base + nt) { transpose_tile(t, tile - base, smem); tile += nworkers; }
    base += nt;
  }
  __syncthreads();
}
__device__ __forceinline__ void rwkv_scan_phase(const Params& p, char* smem) {
  const int nb = gridDim.x, b = blockIdx.x;
  if (nb == 512) {
    if (b < 128) { int sc = b >> 1; rwkv_scan_item<1>(p, 1, sc >> 5, (sc >> 1) & 15, sc & 1, b & 1, smem); }
    else
      for (int it = b - 128; it < 1024; it += nb - 128) rwkv_scan_item<2>(p, 0, it >> 5, (it >> 1) & 15, it & 1, 0, smem);
    if (b < 128) { deferred_transposes(p, smem, b, 256); mod_gemv_items(p, smem, 384, 768, b, 256); }
    else if (b >= 384) { deferred_transposes(p, smem, 128 + (b - 384), 256); mod_gemv_items(p, smem, 384, 768, 128 + (b - 384), 256); }
  } else if (nb >= 256) {
    if (b < 128) { int sc = b >> 1; rwkv_scan_item<1>(p, 1, sc >> 5, (sc >> 1) & 15, sc & 1, b & 1, smem); }
    else
      for (int it = b - 128; it < 1024; it += nb - 128) rwkv_scan_item<2>(p, 0, it >> 5, (it >> 1) & 15, it & 1, 0, smem);
  } else {
    for (int it = b; it < 1088; it += nb) {
      if (it < 64) rwkv_scan_item<2>(p, 1, it >> 5, (it >> 1) & 15, it & 1, 0, smem);
      else { int i2 = it - 64; rwkv_scan_item<2>(p, 0, i2 >> 5, (i2 >> 1) & 15, i2 & 1, 0, smem); }
    }
  }
}
__device__ __forceinline__ float row_sum(float v) {
  v += DPPF(v, 0xB1);
  v += DPPF(v, 0x4E);
  v += DPPF(v, 0x141);
  v += DPPF(v, 0x140);
  return v;
}
__device__ __forceinline__ void rwkv_post_phase(const Params& p) {
  char* ws = p.ws;
  const int lane = threadIdx.x & 63;
  const int gw = blockIdx.x * 4 + (threadIdx.x >> 6), nw = gridDim.x * 4;
  const bf16_t* RKVG = (const bf16_t*)(ws + L1_RKVG);
  const bf16_t* AA = (const bf16_t*)(ws + L1_AA);
  const float* Y = (const float*)(ws + L1_Y);
  bf16_t* OB = (bf16_t*)(ws + OFF_OB);
  for (int item = gw; item < T_ * 4; item += nw) {
    const long t = item >> 2;
    const int c0 = (item & 3) * 256 + lane * 4;
    const uint2 r2 = *(const uint2*)(RKVG + t * 4096 + c0);
    const uint2 k2 = *(const uint2*)(RKVG + t * 4096 + 1024 + c0);
    const uint2 v2 = *(const uint2*)(RKVG + t * 4096 + 2048 + c0);
    const uint2 g2 = *(const uint2*)(RKVG + t * 4096 + 3072 + c0);
    const uint2 a0h = *(const uint2*)(AA + t * 1024 + c0);
    const uint2 a1h = *(const uint2*)(AA + (long)T_ * 1024 + t * 1024 + c0);
    const float4 y0 = *(const float4*)(Y + t * 1024 + c0);
    const float4 y1 = *(const float4*)(Y + (long)T_ * 1024 + t * 1024 + c0);
    const float4 ka = *(const float4*)(p.in[27] + c0);
    const float4 rk = *(const float4*)(p.in[28] + c0);
    const float4 gn = *(const float4*)(p.in[29] + c0);
    const float r[4] = {bf2f(r2.x & 0xffff), bf2f(r2.x >> 16), bf2f(r2.y & 0xffff), bf2f(r2.y >> 16)};
    const float k[4] = {bf2f(k2.x & 0xffff), bf2f(k2.x >> 16), bf2f(k2.y & 0xffff), bf2f(k2.y >> 16)};
    const float v[4] = {bf2f(v2.x & 0xffff), bf2f(v2.x >> 16), bf2f(v2.y & 0xffff), bf2f(v2.y >> 16)};
    const float g[4] = {bf2f(g2.x & 0xffff), bf2f(g2.x >> 16), bf2f(g2.y & 0xffff), bf2f(g2.y >> 16)};
    const float as[4] = {bf2f(a0h.x & 0xffff) + bf2f(a1h.x & 0xffff), bf2f(a0h.x >> 16) + bf2f(a1h.x >> 16),
                         bf2f(a0h.y & 0xffff) + bf2f(a1h.y & 0xffff), bf2f(a0h.y >> 16) + bf2f(a1h.y >> 16)};
    const float kav[4] = {ka.x, ka.y, ka.z, ka.w};
    const float rkv[4] = {rk.x, rk.y, rk.z, rk.w};
    const float gnv[4] = {gn.x, gn.y, gn.z, gn.w};
    float y[4] = {y0.x + y1.x, y0.y + y1.y, y0.z + y1.z, y0.w + y1.w};
    float bs = 0.f, ys = 0.f;
#pragma unroll
    for (int e = 0; e < 4; ++e) {
      bs += r[e] * (k[e] * (2.f + (as[e] - 2.f) * kav[e])) * rkv[e];
      ys += y[e];
    }
    const float bsum = row_sum(bs);
    const float mean = row_sum(ys) * (1.f / 64.f);
    float vs = 0.f;
#pragma unroll
    for (int e = 0; e < 4; ++e) { y[e] -= mean; vs += y[e] * y[e]; }
    const float rinv = rsqrtf(row_sum(vs) * (1.f / 64.f) + 1e-5f);
    float o[4];
#pragma unroll
    for (int e = 0; e < 4; ++e) o[e] = (y[e] * rinv * gnv[e] + bsum * v[e]) * silu_f(g[e]);
    *(uint2*)(OB + t * 1024 + c0) = make_uint2(pack2(o[0], o[1]), pack2(o[2], o[3]));
  }
}

__device__ __forceinline__ float diff_lambda(const Params& p, int lane, float lam_init) {
  const float* lp = p.in[32];
  float a = wave_sum(lp[lane] * lp[64 + lane]);
  float b = wave_sum(lp[128 + lane] * lp[192 + lane]);
  return __expf(a) - __expf(b) + lam_init;
}
#define LAM_INIT_2 0.47071302f

template <int NC, int DV, bool sample>
__device__ __forceinline__ void attn_item(const Params& p, int seq, int h, int qb, float lam, char* smem) {
  constexpr bool NA = (NC == 1);
  constexpr int KW = NC * 64;
  constexpr int NH = 1024 / KW;
  constexpr int KS = 72;
  constexpr int VS = 72;
  constexpr int NDT = DV / 16;
  constexpr int OSS = DV + 4;
  char* ws = p.ws;
  bf16_t* Ks = (bf16_t*)smem;
  bf16_t* Vs = Ks + 64 * KS;
  float* Os = (float*)(Vs + DV * VS);
  const int tid = threadIdx.x, lane = tid & 63, w = tid >> 6, l15 = lane & 15, q4 = lane >> 4;
  constexpr int Lk = sample ? 1280 : 256;
  const long tok0 = sample ? (long)TP_ + seq * 1024 : (long)seq * 256;
  const long q_tok = tok0 + qb * 64 + w * 16 + l15;
  constexpr int kstride = sample ? KW : 1024;
  const bf16_t* Kb = sample ? (const bf16_t*)(ws + L2_KALL) + (long)(seq * NH + h) * 1280 * KW
                            : (const bf16_t*)(ws + L2_KP) + tok0 * 1024 + h * KW;
  const bf16_t* Vb = sample ? (const bf16_t*)(ws + L2_VTS) + (long)(seq * NH + h) * DV * 1280
                            : (const bf16_t*)(ws + L2_VTP) + (long)(seq * NH + h) * DV * 256;
  const int rs = min(max(qb - 4, 0), 8);
  const int qc = w * 16 + l15;
  const int cs = min(max(qc - 8, 0), 48);
  const float* bt = p.in[36] + h * 465;
  constexpr int ntiles = (NA && sample) ? 12 : (Lk >> 6);
  f32x4 O[NDT];
  float lsum = 0.f;
  bf16x8 qf[2];
  float mrun = -INFINITY, lrun = 0.f;
  constexpr int npass = NC * ntiles;
  uint4 kr0, kr1, vr0, vr1, vr2 = make_uint4(0, 0, 0, 0), vr3 = make_uint4(0, 0, 0, 0);
  const int ldrow = tid >> 3, ldch = tid & 7;
#define ATT_LOAD(pi)                                                                                   \
  {                                                                                                    \
    const int c_ = (pi) / ntiles, ti_ = (pi) - c_ * ntiles;                                            \
    const int kt_ = (NA && sample) ? (ti_ < 8 ? rs + ti_ : 8 + ti_) : ti_;                             \
    const int key0_ = kt_ * 64;                                                                        \
    kr0 = *(const uint4*)(Kb + (long)(key0_ + ldrow) * kstride + c_ * 64 + ldch * 8);                  \
    kr1 = *(const uint4*)(Kb + (long)(key0_ + ldrow + 32) * kstride + c_ * 64 + ldch * 8);             \
    vr0 = *(const uint4*)(Vb + (long)ldrow * Lk + key0_ + ldch * 8);                                   \
    vr1 = *(const uint4*)(Vb + (long)(ldrow + 32) * Lk + key0_ + ldch * 8);                            \
    if (DV > 64) {                                                                                     \
      vr2 = *(const uint4*)(Vb + (long)(ldrow + 64) * Lk + key0_ + ldch * 8);                          \
      vr3 = *(const uint4*)(Vb + (long)(ldrow + 96) * Lk + key0_ + ldch * 8);                          \
    }                                                                                                  \
  }
  ATT_LOAD(0)
#pragma unroll 1
  for (int pi = 0; pi < npass; ++pi) {
    const int c = pi / ntiles, ti = pi - c * ntiles;
    if (ti == 0) {
      const bf16_t* Q = (const bf16_t*)(ws + L2_Q) + q_tok * 1024 + h * KW + c * 64;
      qf[0] = *(const bf16x8*)(Q + q4 * 8);
      qf[1] = *(const bf16x8*)(Q + 32 + q4 * 8);
      mrun = -INFINITY; lrun = 0.f;
#pragma unroll
      for (int dt = 0; dt < NDT; ++dt) O[dt] = (f32x4){0.f, 0.f, 0.f, 0.f};
    }
    const int kt = (NA && sample) ? (ti < 8 ? rs + ti : 8 + ti) : ti;
    __syncthreads();
    *(uint4*)(Ks + ldrow * KS + ldch * 8) = kr0;
    *(uint4*)(Ks + (ldrow + 32) * KS + ldch * 8) = kr1;
    *(uint4*)(Vs + ldrow * VS + ldch * 8) = vr0;
    *(uint4*)(Vs + (ldrow + 32) * VS + ldch * 8) = vr1;
    if (DV > 64) {
      *(uint4*)(Vs + (ldrow + 64) * VS + ldch * 8) = vr2;
      *(uint4*)(Vs + (ldrow + 96) * VS + ldch * 8) = vr3;
    }
    __syncthreads();
    if (pi + 1 < npass) ATT_LOAD(pi + 1)
    {
      f32x4 s[4];
#pragma unroll
      for (int st = 0; st < 4; ++st) {
        s[st] = (f32x4){0.f, 0.f, 0.f, 0.f};
#pragma unroll
        for (int ks = 0; ks < 2; ++ks) {
          bf16x8 a = *(const bf16x8*)(Ks + (st * 16 + l15) * KS + ks * 32 + q4 * 8);
          s[st] = __builtin_amdgcn_mfma_f32_16x16x32_f16(a, qf[ks], s[st], 0, 0, 0);
        }
      }
      float mx = -INFINITY;
#pragma unroll
      for (int st = 0; st < 4; ++st)
#pragma unroll
        for (int j = 0; j < 4; ++j) {
          float val = s[st][j] * 0.125f;
          if (NA && sample && kt < 16) {
            int kc = st * 16 + q4 * 4 + j;
            bool ok = (kc >= cs) && (kc < cs + 16);
            int ro = kt - qb + 7;
            int co = min(max(kc - qc, -15), 15) + 15;
            val = ok ? val + bt[ro * 31 + co] : -INFINITY;
          }
          s[st][j] = val;
          mx = fmaxf(mx, val);
        }
      mx = fmaxf(mx, __shfl_xor(mx, 16));
      mx = fmaxf(mx, __shfl_xor(mx, 32));
      const float mnew = fmaxf(mrun, mx);
      const float alpha = __expf(mrun - mnew);
      mrun = mnew;
      float psum = 0.f;
#pragma unroll
      for (int st = 0; st < 4; ++st)
#pragma unroll
        for (int j = 0; j < 4; ++j) {
          float pv = __expf(s[st][j] - mnew);
          s[st][j] = pv;
          psum += pv;
        }
      lrun = lrun * alpha + psum;
#pragma unroll
      for (int dt = 0; dt < NDT; ++dt) {
        O[dt][0] *= alpha; O[dt][1] *= alpha; O[dt][2] *= alpha; O[dt][3] *= alpha;
      }
#pragma unroll
      for (int pp = 0; pp < 2; ++pp) {
        bf16x8 pf;
#pragma unroll
        for (int j = 0; j < 4; ++j) { pf[j] = (_Float16)s[2 * pp][j]; pf[4 + j] = (_Float16)s[2 * pp + 1][j]; }
#pragma unroll
        for (int dt = 0; dt < NDT; ++dt) {
          const bf16_t* vr = Vs + (dt * 16 + l15) * VS + pp * 32 + q4 * 4;
          uint2 lo = *(const uint2*)vr, hi = *(const uint2*)(vr + 16);
          uint4 av = make_uint4(lo.x, lo.y, hi.x, hi.y);
          O[dt] = __builtin_amdgcn_mfma_f32_16x16x32_f16(__builtin_bit_cast(bf16x8, av), pf, O[dt], 0, 0, 0);
        }
      }
    }
    if (ti == ntiles - 1) {
      lrun += __shfl_xor(lrun, 16);
      lrun += __shfl_xor(lrun, 32);
      lsum = lrun;
      if (!NA && c == 0) {
        const float il = __builtin_amdgcn_rcpf(lrun);
        float* os = Os + (w * 16 + l15) * OSS + q4 * 4;
#pragma unroll
        for (int dt = 0; dt < NDT; ++dt)
          *(float4*)(os + dt * 16) = make_float4(O[dt][0] * il, O[dt][1] * il, O[dt][2] * il, O[dt][3] * il);
      }
    }
  }
#undef ATT_LOAD
  const bf16_t* G = (const bf16_t*)(ws + L2_G) + q_tok * 1024 + h * DV;
  bf16_t* OB = (bf16_t*)(ws + OFF_OB) + q_tok * 1024 + h * DV;
  if (NA) {
    const float il = __builtin_amdgcn_rcpf(lsum);
#pragma unroll
    for (int dt = 0; dt < NDT; ++dt) {
      int dv = dt * 16 + q4 * 4;
      uint2 gg = *(const uint2*)(G + dv);
      float g0 = bf2f(gg.x & 0xffff), g1 = bf2f(gg.x >> 16), g2 = bf2f(gg.y & 0xffff), g3 = bf2f(gg.y >> 16);
      *(uint2*)(OB + dv) = make_uint2(pack2(O[dt][0] * il * silu_f(g0), O[dt][1] * il * silu_f(g1)),
                                      pack2(O[dt][2] * il * silu_f(g2), O[dt][3] * il * silu_f(g3)));
    }
  } else {
    const float i1 = lam * __builtin_amdgcn_rcpf(lsum);
    const float* os = Os + (w * 16 + l15) * OSS + q4 * 4;
    float ss = 0.f;
#pragma unroll
    for (int dt = 0; dt < NDT; ++dt) {
      float4 o0 = *(const float4*)(os + dt * 16);
      O[dt][0] = o0.x - O[dt][0] * i1; O[dt][1] = o0.y - O[dt][1] * i1;
      O[dt][2] = o0.z - O[dt][2] * i1; O[dt][3] = o0.w - O[dt][3] * i1;
      ss += O[dt][0] * O[dt][0] + O[dt][1] * O[dt][1] + O[dt][2] * O[dt][2] + O[dt][3] * O[dt][3];
    }
    ss += __shfl_xor(ss, 16);
    ss += __shfl_xor(ss, 32);
    const float rinv = rsqrtf(ss * (1.f / DV) + 1e-6f) * (1.f - LAM_INIT_2);
    const float* gn = p.in[33] + h * DV;
#pragma unroll
    for (int dt = 0; dt < NDT; ++dt) {
      int dv = dt * 16 + q4 * 4;
      uint2 gg = *(const uint2*)(G + dv);
      float4 gw = *(const float4*)(gn + dv);
      float g0 = bf2f(gg.x & 0xffff), g1 = bf2f(gg.x >> 16), g2 = bf2f(gg.y & 0xffff), g3 = bf2f(gg.y >> 16);
      *(uint2*)(OB + dv) = make_uint2(pack2(O[dt][0] * rinv * gw.x * silu_f(g0), O[dt][1] * rinv * gw.y * silu_f(g1)),
                                      pack2(O[dt][2] * rinv * gw.z * silu_f(g2), O[dt][3] * rinv * gw.w * silu_f(g3)));
    }
  }
}
__device__ __forceinline__ void diff_attn_phase(const Params& p, char* smem) {
  const int lane = threadIdx.x & 63;
  const float lam = diff_lambda(p, lane, LAM_INIT_2);
  const int b = blockIdx.x, nb = gridDim.x;
  const bool split = nb >= 512;
  int it = split ? (b < 256 ? b : 256 + (b - 256)) : b;
  const int step = split ? (b < 256 ? 1 << 30 : nb - 256) : nb;
  for (; it < 1280; it += step) {
    bool sample = it < 256;
    int i2 = sample ? it : it - 256;
    int seq = sample ? (i2 >> 7) : (i2 >> 5);
    int h = sample ? ((i2 >> 4) & 7) : ((i2 >> 2) & 7);
    int qb = sample ? (i2 & 15) : (i2 & 3);
    if (sample) attn_item<2, 128, true>(p, seq, h, qb, lam, smem);
    else attn_item<2, 128, false>(p, seq, h, qb, lam, smem);
    if (step == (1 << 30)) break;
  }
}
__device__ __forceinline__ void na_attn_phase(const Params& p, char* smem) {
  const int b = blockIdx.x, nb = gridDim.x;
  for (int it = b; it < 2560; it += nb) {
    bool sample = it < 512;
    int i2 = sample ? it : it - 512;
    int seq = sample ? (i2 >> 8) : (i2 >> 6);
    int h = sample ? ((i2 >> 4) & 15) : ((i2 >> 2) & 15);
    int qb = sample ? (i2 & 15) : (i2 & 3);
    if (sample) attn_item<1, 64, true>(p, seq, h, qb, 0.f, smem);
    else attn_item<1, 64, false>(p, seq, h, qb, 0.f, smem);
  }
}

#define OFF_BAR (512l * 1024)
#define XB_TMO      128
#define XB_XCNT(j)  (256  + 64 * (j))
#define XB_XSUB(j)  (1280 + 64 * (j))
#define XB_XGEN(j)  (2304 + 64 * (j))
#define XB_TOP      3328
#define XB_TOPGEN   3392
#define XB_RANK(j)  (3456 + 64 * (j))
#define XCD_BAR_WORDS 4480
#define XB_SPIN_CAP (1u << 20)
#define LAS __attribute__((address_space(3)))
__device__ __forceinline__ unsigned xb_ld(unsigned* p)              { return __hip_atomic_load(p, __ATOMIC_RELAXED, __HIP_MEMORY_SCOPE_AGENT); }
__device__ __forceinline__ unsigned xb_add(unsigned* p, unsigned v) { return __hip_atomic_fetch_add(p, v, __ATOMIC_RELAXED, __HIP_MEMORY_SCOPE_AGENT); }
__device__ __forceinline__ unsigned xb_xcc_id() { return (unsigned)__builtin_amdgcn_s_getreg((3 << 11) | 20) & 0xFu; }
#define XB_SPIN(cond, bar) do { unsigned _sp = 0; while (cond) { __builtin_amdgcn_s_sleep(1); \
    if ((++_sp & 255u) == 0u) { if (xb_ld(&(bar)[XB_TMO])) break; if (_sp > XB_SPIN_CAP) { atomicAdd(&(bar)[XB_TMO], 1u); break; } } } } while (0)
struct XcdBarrier { unsigned* bar; unsigned x; volatile LAS unsigned* st; };
__device__ __forceinline__ XcdBarrier xcd_barrier_post(unsigned* bar, volatile LAS unsigned* st) {
  XcdBarrier b; b.bar = bar; b.x = xb_xcc_id(); b.st = st;
  if (threadIdx.x == 0) (void)xb_add(&bar[XB_XCNT(b.x)], 1u);
  return b;
}
__device__ __forceinline__ void xcd_barrier_complete(unsigned* bar, unsigned x, unsigned& nloc, unsigned& nx) {
  const unsigned G = gridDim.x * gridDim.y * gridDim.z;
  unsigned sum, cnt, mine, sp = 0u;
  for (;;) {
    sum = 0u; cnt = 0u; mine = 0u;
#pragma unroll
    for (unsigned j = 0; j < 16; ++j) { const unsigned c = xb_ld(&bar[XB_XCNT(j)]); sum += c; cnt += (c > 0u) ? 1u : 0u; mine = (j == x) ? c : mine; }
    if (sum == G) break;
    __builtin_amdgcn_s_sleep(1);
    if ((++sp & 255u) == 0u) { if (xb_ld(&bar[XB_TMO])) break; if (sp > XB_SPIN_CAP) { atomicAdd(&bar[XB_TMO], 1u); break; } }
  }
  nloc = mine > 0u ? mine : 1u; nx = cnt > 0u ? cnt : 1u;
}
__device__ __forceinline__ void xcd_barrier(const XcdBarrier& b) {
  asm volatile("s_waitcnt vmcnt(0)" ::: "memory");
  __syncthreads();
  if (threadIdx.x == 0) {
    unsigned* bar = b.bar;
    __builtin_amdgcn_s_waitcnt(0);
    unsigned nloc = b.st[0], nx = b.st[1];
    if (nloc == 0u) { xcd_barrier_complete(bar, b.x, nloc, nx); b.st[0] = nloc; b.st[1] = nx; }
    const unsigned old = xb_add(&bar[XB_XSUB(b.x)], 1u);
    const unsigned gen = old / nloc;
    if (old + 1u == (gen + 1u) * nloc) {
      __builtin_amdgcn_fence(__ATOMIC_RELEASE, "agent");
      asm volatile("s_waitcnt vmcnt(0)" ::: "memory");
      const unsigned og = xb_add(&bar[XB_TOP], 1u);
      const unsigned tg = og / nx;
      if (og + 1u == (tg + 1u) * nx) xb_add(&bar[XB_TOPGEN], 1u);
      else XB_SPIN(xb_ld(&bar[XB_TOPGEN]) == tg, bar);
      __builtin_amdgcn_fence(__ATOMIC_ACQUIRE, "agent");
      xb_add(&bar[XB_XGEN(b.x)], 1u);
      asm volatile("s_waitcnt vmcnt(0)" ::: "memory");
    } else {
      XB_SPIN(xb_ld(&bar[XB_XGEN(b.x)]) == gen, bar);
      __builtin_amdgcn_fence(__ATOMIC_ACQUIRE, "agent");
      asm volatile("s_waitcnt vmcnt(0)" ::: "memory");
    }
  }
  __syncthreads();
}

#define N_PHASES 27
#define N_PHASES 22
#define GSYNC(k) { xcd_barrier(xb); }
#define PH(k, body)                                   \
  if (ph_lo <= (k) && (k) < ph_hi) { body; }          \
  if (ph_lo <= (k) && (k) + 1 < ph_hi) GSYNC(k)
__global__ void __launch_bounds__(256, 2) mega(Params p, int ph_lo, int ph_hi) {
  __shared__ __attribute__((aligned(16))) char smem[73728];
  __shared__ uint4 xb_words;
  cg::grid_group grid = cg::this_grid();
  unsigned* bar = (unsigned*)(p.ws + OFF_BAR);
  if (threadIdx.x == 0) xb_words = make_uint4(0u, 0u, 0u, 0u);
  __syncthreads();
  if (ph_lo < 0) grid.sync();
  XcdBarrier xb = xcd_barrier_post(bar, (volatile LAS unsigned*)&xb_words);
  int vb = blockIdx.x;
  PH(0, prep_phase(p, smem))
  PH(1, norm_phase(p, 0))
  PH(2, gemm_phase(p, 0, smem, vb); if (gridDim.x == 512) { transposes_subset(p, smem, 0xFF0Eu, blockIdx.x, 512); mod_gemv_items(p, smem, 192, 384, blockIdx.x, 512); })
  PH(3, gemm_phase(p, 1, smem, vb))
  PH(4, gemm_phase(p, 2, smem, vb))
  PH(5, ret_ln_phase(p))
  PH(6, gemm_phase(p, 3, smem, vb))
  PH(7, norm_phase(p, 1))
  PH(8, gemm_phase(p, 4, smem, vb))
  PH(9, gemm_phase(p, 5, smem, vb))
  PH(10, rwkv_scan_phase(p, smem))
  PH(11, rwkv_post_phase(p))
  PH(12, gemm_phase(p, 6, smem, vb))
  PH(13, norm_phase(p, 2); diff_cache_prep(p))
  PH(14, gemm_phase(p, 7, smem, vb))
  PH(15, diff_attn_phase(p, smem))
  PH(16, gemm_phase(p, 10, smem, vb))
  PH(17, norm_phase(p, 3); na_cache_prep(p))
  PH(18, gemm_phase(p, 11, smem, vb))
  PH(19, na_attn_phase(p, smem))
  PH(20, gemm_phase(p, 14, smem, vb))
  PH(21, final_norm_phase(p))
}

extern "C" void kernel_launch(void* const* d_in, const int* in_sizes, int n_in,
                              void* d_out, int out_size, void* d_ws, size_t ws_size,
                              hipStream_t stream) {
  static int grid_blocks = 0;
  if (!grid_blocks) {
    int dev = 0, cus = 0, per_cu = 0;
    (void)hipGetDevice(&dev);
    (void)hipDeviceGetAttribute(&cus, hipDeviceAttributeMultiprocessorCount, dev);
    (void)hipOccupancyMaxActiveBlocksPerMultiprocessor(&per_cu, mega, 256, 0);
    if (per_cu > 2) per_cu = 2;
    if (per_cu < 1) per_cu = 1;
    grid_blocks = cus * per_cu;
  }
  Params p{};
  for (int i = 0; i < 38; ++i) p.in[i] = (const float*)d_in[i];
  p.out = (float*)d_out;
  p.ws = (char*)d_ws;
  int lo = 0, hi = N_PHASES;
  (void)hipMemsetAsync((char*)d_ws + OFF_BAR, 0, XCD_BAR_WORDS * 4, stream);
  void* args[] = {&p, &lo, &hi};
  hipError_t e = hipLaunchCooperativeKernel((void*)mega, dim3(grid_blocks), dim3(256), args, 0, stream);
  if (e != hipSuccess) fprintf(stderr, "cooperative launch failed: %s (grid %d)\n", hipGetErrorString(e), grid_blocks);
}
```

```cpp
#include <hip/hip_runtime.h>
#include <hip/hip_cooperative_groups.h>
#include <cstdio>
namespace cg = cooperative_groups;

typedef unsigned short bf16_t;
using bf16x8 = __attribute__((ext_vector_type(8))) _Float16;
using f32x4 = __attribute__((ext_vector_type(4))) float;
typedef float v2f __attribute__((ext_vector_type(2)));

#define TP_ 8192
#define T_ 10240
#define MIB (1l << 20)

#define OFF_MOD 0l
#define OFF_TAB (256l * 1024)
#define OFF_WT_RET_IN (1 * MIB)
#define OFF_WT_RET_OUT (13 * MIB)
#define OFF_WT_RWKV_IN (17 * MIB)
#define OFF_WT_RWKV_OUT (25 * MIB)
#define OFF_WT_DIFF_IN (27 * MIB)
#define OFF_WT_DIFF_OUT (35 * MIB)
#define OFF_WT_NA_IN (37 * MIB)
#define OFF_WT_NA_OUT (45 * MIB)
#define OFF_WT_LDOWN (47 * MIB)
#define OFF_WT_LUP (47 * MIB + 512 * 1024)
#define ARENA (48 * MIB)
#define OFF_H (ARENA + 0 * MIB)
#define OFF_SH (ARENA + 20 * MIB)
#define OFF_OB (ARENA + 40 * MIB)
#define L0_Q (ARENA + 80 * MIB)
#define L0_K (ARENA + 100 * MIB)
#define L0_G (ARENA + 120 * MIB)
#define L0_VTP (ARENA + 160 * MIB)
#define L0_VTS (ARENA + 192 * MIB)
#define L0_KT (ARENA + 208 * MIB)
#define L0_SP (ARENA + 240 * MIB)
#define L0_PEXT (ARENA + 256 * MIB)
#define L0_O (ARENA + 280 * MIB)
#define L1_RKVG (ARENA + 80 * MIB)
#define L1_L (ARENA + 160 * MIB)
#define L1_DEC (ARENA + 168 * MIB)
#define L1_AA (ARENA + 248 * MIB)
#define L1_Y (ARENA + 328 * MIB)
#define L1_XM (ARENA + 0 * MIB)
#define L1_XW (ARENA + 328 * MIB)
#define L2_O (ARENA + 0 * MIB)
#define L2_Q (ARENA + 60 * MIB)
#define L2_KP (ARENA + 80 * MIB)
#define L2_G (ARENA + 100 * MIB)
#define L2_VTP (ARENA + 120 * MIB)
#define L2_VTS (ARENA + 136 * MIB)
#define L2_KALL (ARENA + 144 * MIB)
#define L2_S1P (ARENA + 152 * MIB)
#define L2_S2P (ARENA + 216 * MIB)
#define L2_S1S (ARENA + 280 * MIB)
#define L2_S2S (ARENA + 360 * MIB)
#define L3_SP (ARENA + 152 * MIB)
#define L3_SS (ARENA + 280 * MIB)

#define OUT_STATE_RET 10485760l
#define OUT_STATE_RWKV 44040192l
#define OUT_DIFF_K 48234496l
#define OUT_DIFF_V 56623104l
#define OUT_NA_K 65011712l
#define OUT_NA_V 73400320l

struct Params {
  const float* in[38];
  float* out;
  char* ws;
};

__device__ __forceinline__ bf16_t f2bf(float f) {
  _Float16 h = (_Float16)f;
  return __builtin_bit_cast(unsigned short, h);
}
__device__ __forceinline__ float bf2f(unsigned h) { return (float)__builtin_bit_cast(_Float16, (unsigned short)h); }
__device__ __forceinline__ unsigned pack2(float a, float b) { return (unsigned)f2bf(a) | ((unsigned)f2bf(b) << 16); }
#define DPPF(x, ctrl) __builtin_bit_cast(float, __builtin_amdgcn_mov_dpp(__builtin_bit_cast(int, (x)), (ctrl), 0xF, 0xF, true))
#define RDLANE(x, l) __builtin_bit_cast(float, __builtin_amdgcn_readlane(__builtin_bit_cast(int, (x)), (l)))
__device__ __forceinline__ float wave_sum(float v) {
  v += DPPF(v, 0xB1);
  v += DPPF(v, 0x4E);
  v += DPPF(v, 0x141);
  v += DPPF(v, 0x140);
  return (RDLANE(v, 0) + RDLANE(v, 16)) + (RDLANE(v, 32) + RDLANE(v, 48));
}
__device__ __forceinline__ float wave_max(float v) {
  v = fmaxf(v, DPPF(v, 0xB1));
  v = fmaxf(v, DPPF(v, 0x4E));
  v = fmaxf(v, DPPF(v, 0x141));
  v = fmaxf(v, DPPF(v, 0x140));
  return fmaxf(fmaxf(RDLANE(v, 0), RDLANE(v, 16)), fmaxf(RDLANE(v, 32), RDLANE(v, 48)));
}
__device__ __forceinline__ void nt_store4(float* ptr, float a, float b, float c, float d) {
  f32x4 v = {a, b, c, d};
  __builtin_nontemporal_store(v, (f32x4*)ptr);
}
__device__ __forceinline__ float silu_f(float x) { return x * __builtin_amdgcn_rcpf(1.f + __expf(-x)); }
__device__ __forceinline__ int perm_ret(int c) {
  int half = c >> 7, r = c & 127;
  return half * 128 + (r & 1) * 64 + (r >> 1);
}
__device__ __forceinline__ int perm_diff(int c) {
  int rr = c & 31;
  return (c & ~31) + (rr & 1) * 16 + (rr >> 1);
}

enum { EPI_F32 = 0, EPI_RET_IN, EPI_RET_S, EPI_OUT, EPI_BF16, EPI_LUP_W, EPI_LUP_A, EPI_DIFF_IN, EPI_NA_IN, EPI_NA_PV };

struct GemmDesc {
  const bf16_t* A; const bf16_t* B;
  long lda, ldb;
  int M, N, K;
  int nb1, nb2;
  long sA1, sA2, sB1, sB2;
  int epi, bn64, flag, layer;
  float* C; long ldc, sC1, sC2; float scale;
  const float* aux;
};

__device__ __forceinline__ void epilogue(const Params& p, const GemmDesc& g, int b1, int b2, int m, int n, f32x4 v) {
  char* ws = p.ws;
  switch (g.epi) {
    case EPI_F32: {
      int mm = m;
      if (g.flag & 1) mm = perm_ret(m);
      float4 o = make_float4(v[0] * g.scale, v[1] * g.scale, v[2] * g.scale, v[3] * g.scale);
      if (g.flag & 2) *(uint2*)((bf16_t*)g.C + b1 * g.sC1 + b2 * g.sC2 + (long)mm * g.ldc + n) = make_uint2(pack2(o.x, o.y), pack2(o.z, o.w));
      else if (g.flag & 1) nt_store4(g.C + b1 * g.sC1 + b2 * g.sC2 + (long)mm * g.ldc + n, o.x, o.y, o.z, o.w);
      else *(float4*)(g.C + b1 * g.sC1 + b2 * g.sC2 + (long)mm * g.ldc + n) = o;
    } break;
    case EPI_BF16: {
      float a0 = v[0], a1 = v[1], a2 = v[2], a3 = v[3];
      if (g.flag & 1) {
        a0 = 1.f - 2.f * __builtin_amdgcn_rcpf(__expf(2.f * a0) + 1.f); a1 = 1.f - 2.f * __builtin_amdgcn_rcpf(__expf(2.f * a1) + 1.f);
        a2 = 1.f - 2.f * __builtin_amdgcn_rcpf(__expf(2.f * a2) + 1.f); a3 = 1.f - 2.f * __builtin_amdgcn_rcpf(__expf(2.f * a3) + 1.f);
      }
      uint2 o = make_uint2(pack2(a0, a1), pack2(a2, a3));
      *(uint2*)((bf16_t*)g.C + (long)m * g.ldc + n) = o;
    } break;
    case EPI_OUT: {
      int cond = (m < TP_) ? 0 : 1 + ((m - TP_) >> 10);
      const float* gate = (const float*)(ws + OFF_MOD) + ((long)g.layer * 3 + cond) * 3072 + 2048 + n;
      const float* res;
      if (g.layer == 0) res = (m < TP_) ? p.in[0] + (long)m * 1024 + n : p.in[1] + (long)(m - TP_) * 1024 + n;
      else res = p.out + (long)m * 1024 + n;
      float4 r = *(const float4*)res;
      float4 gt = *(const float4*)gate;
      float4 o = make_float4(r.x + gt.x * v[0], r.y + gt.y * v[1], r.z + gt.z * v[2], r.w + gt.w * v[3]);
      *(float4*)(p.out + (long)m * 1024 + n) = o;
    } break;
    case EPI_LUP_W: {
      const float4 w4 = *(const float4*)(g.aux + n);
      const float w0[4] = {w4.x, w4.y, w4.z, w4.w};
      float o[4];
#pragma unroll
      for (int j = 0; j < 4; ++j) o[j] = 0.6065306597126334f * __builtin_amdgcn_rcpf(1.f + __expf(-(w0[j] + v[j])));
      *(uint2*)((bf16_t*)g.C + (long)m * 1024 + n) = make_uint2(pack2(o[0], o[1]), pack2(o[2], o[3]));
    } break;
    case EPI_LUP_A: {
      const float4 a4 = *(const float4*)(g.aux + n);
      const float a0[4] = {a4.x, a4.y, a4.z, a4.w};
      float o[4];
#pragma unroll
      for (int j = 0; j < 4; ++j) o[j] = __builtin_amdgcn_rcpf(1.f + __expf(-(a0[j] + v[j])));
      *(uint2*)((bf16_t*)g.C + (long)m * 1024 + n) = make_uint2(pack2(o[0], o[1]), pack2(o[2], o[3]));
    } break;
    case EPI_RET_IN: {
      const bool sample = m >= TP_;
      const int sb = (m - TP_) >> 10, ls = (m - TP_) & 1023;
      const int pb = m >> 8, lp = m & 255;
      const float* lg = (const float*)(ws + OFF_TAB);
      if (n < 2048) {
        const bool isk = n >= 1024;
        const int c = n & 1023, h = c >> 8, dk = c & 255;
        float x[4] = {v[0], v[1], v[2], v[3]};
        if (isk) { x[0] *= 0.0625f; x[1] *= 0.0625f; x[2] *= 0.0625f; x[3] *= 0.0625f; }
        if (sample) {
          const int half = dk >> 7;
          const float pos = half ? (float)(ls & 63) : (float)(ls >> 6);
#pragma unroll
          for (int pp = 0; pp < 2; ++pp) {
            int i = ((dk & 127) >> 1) + pp;
            float inv = __builtin_amdgcn_exp2f(-(float)i * (13.287712379549449f / 64.f));
            float ang = pos * inv;
            float cs = __cosf(ang), sn = __sinf(ang);
            float x1 = x[2 * pp], x2 = x[2 * pp + 1];
            x[2 * pp] = x1 * cs - x2 * sn;
            x[2 * pp + 1] = x1 * sn + x2 * cs;
          }
        }
        bf16_t* dst = (bf16_t*)(ws + (isk ? L0_K : L0_Q)) + (long)m * 1024 + c;
        *(uint2*)dst = make_uint2(pack2(x[0], x[1]), pack2(x[2], x[3]));
        if (sample && !isk) {
          float df = __expf(lg[h] * (float)(ls + 1));
          float db = __expf(lg[4 + h] * (float)(1024 - ls));
          bf16_t* pe = (bf16_t*)(ws + L0_PEXT) + ((long)(sb * 4 + h) * 1024 + ls) * 1536 + 1024 + dk;
          *(uint2*)pe = make_uint2(pack2(x[0] * df, x[1] * df), pack2(x[2] * df, x[3] * df));
          *(uint2*)(pe + 256) = make_uint2(pack2(x[0] * db, x[1] * db), pack2(x[2] * db, x[3] * db));
        }
        if (!sample && isk) {
          float df = __expf(lg[h] * (float)(255 - lp));
          float db = __expf(lg[4 + h] * (float)lp);
          bf16_t* kt0 = (bf16_t*)(ws + L0_KT) + ((long)((0 * 32 + pb) * 4 + h) * 256 + dk) * 256 + lp;
          bf16_t* kt1 = (bf16_t*)(ws + L0_KT) + ((long)((1 * 32 + pb) * 4 + h) * 256 + dk) * 256 + lp;
#pragma unroll
          for (int j = 0; j < 4; ++j) { kt0[j * 256] = f2bf(x[j] * df); kt1[j * 256] = f2bf(x[j] * db); }
        }
      } else if (n < 4096) {
        const int c = n - 2048, h = c >> 9, dv = c & 511;
        if (sample) {
          bf16_t* vt = (bf16_t*)(ws + L0_VTS) + ((long)(sb * 4 + h) * 512 + dv) * 1536 + ls;
#pragma unroll
          for (int j = 0; j < 4; ++j) vt[j * 1536] = f2bf(v[j]);
        } else {
          bf16_t* vt = (bf16_t*)(ws + L0_VTP) + ((long)(pb * 4 + h) * 512 + dv) * 256 + lp;
#pragma unroll
          for (int j = 0; j < 4; ++j) vt[j * 256] = f2bf(v[j]);
        }
      } else {
        bf16_t* dst = (bf16_t*)(ws + L0_G) + (long)m * 2048 + (n - 4096);
        *(uint2*)dst = make_uint2(pack2(v[0], v[1]), pack2(v[2], v[3]));
      }
    } break;
    case EPI_RET_S: {
      const float* lg = (const float*)(ws + OFF_TAB);
      const float lgf = lg[b2], lgb = lg[4 + b2];
      float o[4];
#pragma unroll
      for (int j = 0; j < 4; ++j) {
        int d = m - (n + j);
        float arg = (d > 0) ? lgf * (float)d : lgb * (float)(-d);
        float f = (d == 0) ? 2.f : __expf(arg);
        o[j] = v[j] * f;
      }
      bf16_t* dst = (bf16_t*)g.C + b1 * g.sC1 + b2 * g.sC2 + (long)m * g.ldc + n;
      *(uint2*)dst = make_uint2(pack2(o[0], o[1]), pack2(o[2], o[3]));
    } break;
    case EPI_DIFF_IN: {
      const bool sample = m >= TP_;
      const int sb = (m - TP_) >> 10, ls = (m - TP_) & 1023;
      const int pb = m >> 8, lp = m & 255;
      if (n < 2048) {
        const bool isk = n >= 1024;
        const int c = n & 1023, h = c >> 7, d = c & 127;
        float x[4] = {v[0], v[1], v[2], v[3]};
        if (sample) {
          const int half = (d >> 5) & 1;
          const float pos = half ? (float)(ls & 63) : (float)(ls >> 6);
#pragma unroll
          for (int pp = 0; pp < 2; ++pp) {
            int i = ((d & 31) >> 1) + pp;
            float inv = __builtin_amdgcn_exp2f(-(float)i * (13.287712379549449f / 16.f));
            float ang = pos * inv;
            float cs = __cosf(ang), sn = __sinf(ang);
            float x1 = x[2 * pp], x2 = x[2 * pp + 1];
            x[2 * pp] = x1 * cs - x2 * sn;
            x[2 * pp + 1] = x1 * sn + x2 * cs;
          }
        }
        uint2 pk = make_uint2(pack2(x[0], x[1]), pack2(x[2], x[3]));
        if (!isk) {
          *(uint2*)((bf16_t*)(ws + L2_Q) + (long)m * 1024 + c) = pk;
        } else if (sample) {
          *(uint2*)((bf16_t*)(ws + L2_KALL) + ((long)(sb * 8 + h) * 1280 + ls) * 128 + d) = pk;
        } else {
          *(uint2*)((bf16_t*)(ws + L2_KP) + (long)m * 1024 + c) = pk;
          float* ck = p.out + OUT_DIFF_K + ((long)(pb * 8 + h) * 256 + lp) * 128 + (d & ~31) + ((d & 31) >> 1);
          *(float2*)ck = make_float2(v[0], v[2]);
          *(float2*)(ck + 16) = make_float2(v[1], v[3]);
        }
      } else if (n < 3072) {
        const int c = n - 2048, h = c >> 7, dv = c & 127;
        if (sample) {
          bf16_t* vt = (bf16_t*)(ws + L2_VTS) + ((long)(sb * 8 + h) * 128 + dv) * 1280 + ls;
#pragma unroll
          for (int j = 0; j < 4; ++j) vt[j * 1280] = f2bf(v[j]);
        } else {
          bf16_t* vt = (bf16_t*)(ws + L2_VTP) + ((long)(pb * 8 + h) * 128 + dv) * 256 + lp;
#pragma unroll
          for (int j = 0; j < 4; ++j) vt[j * 256] = f2bf(v[j]);
          nt_store4(p.out + OUT_DIFF_V + ((long)(pb * 8 + h) * 256 + lp) * 128 + dv, v[0], v[1], v[2], v[3]);
        }
      } else {
        *(uint2*)((bf16_t*)(ws + L2_G) + (long)m * 1024 + (n - 3072)) = make_uint2(pack2(v[0], v[1]), pack2(v[2], v[3]));
      }
    } break;
    case EPI_NA_IN: {
      const bool sample = m >= TP_;
      const int sb = (m - TP_) >> 10, ls = (m - TP_) & 1023;
      const int pb = m >> 8, lp = m & 255;
      uint2 pk = make_uint2(pack2(v[0], v[1]), pack2(v[2], v[3]));
      if (n < 1024) {
        *(uint2*)((bf16_t*)(ws + L2_Q) + (long)m * 1024 + n) = pk;
      } else if (n < 2048) {
        const int c = n - 1024, h = c >> 6, d = c & 63;
        if (sample) {
          *(uint2*)((bf16_t*)(ws + L2_KALL) + ((long)(sb * 16 + h) * 1280 + ls) * 64 + d) = pk;
        } else {
          *(uint2*)((bf16_t*)(ws + L2_KP) + (long)m * 1024 + c) = pk;
          nt_store4(p.out + OUT_NA_K + ((long)(pb * 16 + h) * 256 + lp) * 64 + d, v[0], v[1], v[2], v[3]);
        }
      } else if (n < 3072) {
        const int c = n - 2048, h = c >> 6, dv = c & 63;
        if (sample) {
          bf16_t* vt = (bf16_t*)(ws + L2_VTS) + ((long)(sb * 16 + h) * 64 + dv) * 1280 + ls;
#pragma unroll
          for (int j = 0; j < 4; ++j) vt[j * 1280] = f2bf(v[j]);
        } else {
          bf16_t* vt = (bf16_t*)(ws + L2_VTP) + ((long)(pb * 16 + h) * 64 + dv) * 256 + lp;
#pragma unroll
          for (int j = 0; j < 4; ++j) vt[j * 256] = f2bf(v[j]);
          nt_store4(p.out + OUT_NA_V + ((long)(pb * 16 + h) * 256 + lp) * 64 + dv, v[0], v[1], v[2], v[3]);
        }
      } else {
        *(uint2*)((bf16_t*)(ws + L2_G) + (long)m * 1024 + (n - 3072)) = pk;
      }
    } break;
  }
}

#define LDS_STRIDE 64
typedef __attribute__((address_space(3))) unsigned lds_u32;
template <int NT, int MI>
__device__ __forceinline__ void gemm_tile(const Params& p, const GemmDesc& g, int b1, int b2, int m0, int n0, char* smem) {
  constexpr int BN = NT * 32;
  constexpr int BM = MI * 32;
  bf16_t* As = (bf16_t*)smem;
  bf16_t* Bs = As + 2 * BM * LDS_STRIDE;
  const int tid = threadIdx.x, lane = tid & 63, wave = tid >> 6, wr = wave >> 1, wc = wave & 1, l15 = lane & 15, q4 = lane >> 4;
  const bf16_t* Ab = g.A + b1 * g.sA1 + b2 * g.sA2 + (long)m0 * g.lda;
  const bf16_t* Bb = g.B + b1 * g.sB1 + b2 * g.sB2 + (long)n0 * g.ldb;
  f32x4 acc[MI][NT];
#pragma unroll
  for (int i = 0; i < MI; ++i)
#pragma unroll
    for (int j = 0; j < NT; ++j) acc[i][j] = (f32x4){0.f, 0.f, 0.f, 0.f};
  const int nk = g.K >> 6;
  const int rsw = (l15 >> 1) & 7;
  const int prow = lane >> 3;
  const int gch = (lane & 7) ^ (((wave & 1) << 2) | (prow >> 1));
  const bf16_t* Ag = Ab + (long)(wave * 8 + prow) * g.lda + gch * 8;
  const bf16_t* Bg = Bb + (long)(wave * 8 + prow) * g.ldb + gch * 8;
  const long a32 = 32 * g.lda, b32 = 32 * g.ldb;
#define DMA(kt, buf)                                                                                         \
  {                                                                                                          \
    _Pragma("unroll") for (int i = 0; i < MI; ++i)                                                           \
      __builtin_amdgcn_global_load_lds((const unsigned*)(Ag + i * a32 + (kt) * 64),                          \
          (lds_u32*)((char*)As + (buf) * (BM * 128) + (i * 4 + wave) * 1024 + lane * 16), 16, 0, 0);         \
    _Pragma("unroll") for (int i = 0; i < NT / 1; ++i) if (i < BN / 32)                                      \
      __builtin_amdgcn_global_load_lds((const unsigned*)(Bg + i * b32 + (kt) * 64),                          \
          (lds_u32*)((char*)Bs + (buf) * (BN * 128) + (i * 4 + wave) * 1024 + lane * 16), 16, 0, 0);         \
  }
  bf16x8 af[2][MI], bfr[2][NT];
#define LOADFRAGS(buf)                                                                     \
  _Pragma("unroll") for (int ks = 0; ks < 2; ++ks) {                                       \
    _Pragma("unroll") for (int mi = 0; mi < MI; ++mi)                                      \
      af[ks][mi] = *(const bf16x8*)(As + ((buf) * BM + wr * (MI * 16) + mi * 16 + l15) * LDS_STRIDE + (((ks * 4 + q4) ^ rsw) << 3)); \
    _Pragma("unroll") for (int ni = 0; ni < NT; ++ni)                                      \
      bfr[ks][ni] = *(const bf16x8*)(Bs + ((buf) * BN + wc * (NT * 16) + ni * 16 + l15) * LDS_STRIDE + (((ks * 4 + q4) ^ rsw) << 3)); \
  }
#define COMPUTE()                                                                          \
  _Pragma("unroll") for (int ks = 0; ks < 2; ++ks)                                         \
    _Pragma("unroll") for (int mi = 0; mi < MI; ++mi)                                      \
      _Pragma("unroll") for (int ni = 0; ni < NT; ++ni)                                    \
        acc[mi][ni] = __builtin_amdgcn_mfma_f32_16x16x32_f16(bfr[ks][ni], af[ks][mi], acc[mi][ni], 0, 0, 0);
  DMA(0, 0)
  asm volatile("s_waitcnt vmcnt(0)" ::: "memory");
  __syncthreads();
  for (int kt = 0; kt < nk; ++kt) {
    const int buf = kt & 1;
    LOADFRAGS(buf)
    __builtin_amdgcn_sched_barrier(0);
    if (kt + 1 < nk) DMA(kt + 1, buf ^ 1)
    __builtin_amdgcn_sched_barrier(0);
    COMPUTE()
    __builtin_amdgcn_sched_barrier(0);
    asm volatile("s_waitcnt vmcnt(0)" ::: "memory");
    __syncthreads();
  }
#undef LOADFRAGS
#undef COMPUTE
#undef DMA
#pragma unroll
  for (int mi = 0; mi < MI; ++mi)
#pragma unroll
    for (int ni = 0; ni < NT; ++ni) {
      int m = m0 + wr * (MI * 16) + mi * 16 + l15;
      int n = n0 + wc * (NT * 16) + ni * 16 + q4 * 4;
      epilogue(p, g, b1, b2, m, n, acc[mi][ni]);
    }
}

__device__ __forceinline__ int desc_tiles(const GemmDesc& g) {
  int bn = g.bn64 ? 64 : 128;
  int bm = (g.flag & 256) ? 160 : 128;
  return g.nb1 * g.nb2 * (g.M / bm) * (g.N / bn);
}
__device__ __forceinline__ void run_desc_tile(const Params& p, const GemmDesc& g, int tile, char* smem) {
  int bn = g.bn64 ? 64 : 128;
  int bm = (g.flag & 256) ? 160 : 128;
  int tm = g.M / bm, tn = g.N / bn;
  int per = tm * tn;
  int batch = tile / per, rem = tile - batch * per;
  int nt = rem / tm, mt = rem - nt * tm;
  if (false && g.nb1 * g.nb2 == 1 && (tm & 7) == 0) {
    int snw = tn < 8 ? tn : 8;
    int sz = 8 * snw;
    int sup = rem / sz, within = rem - sup * sz;
    int nsm = tm >> 3;
    int sn = sup / nsm, sm_ = sup - sn * nsm;
    mt = sm_ * 8 + (within & 7);
    nt = sn * snw + (within >> 3);
  }
  int b1 = batch / g.nb2, b2 = batch - b1 * g.nb2;
  if (g.flag & 256) gemm_tile<4, 5>(p, g, b1, b2, mt * 160, nt * 128, smem);
  else if (g.bn64) gemm_tile<2, 4>(p, g, b1, b2, mt * 128, nt * 64, smem);
  else gemm_tile<4, 4>(p, g, b1, b2, mt * 128, nt * 128, smem);
}

__device__ __forceinline__ GemmDesc mkdesc(const void* A, long lda, const void* B, long ldb, int M, int N, int K, int epi) {
  GemmDesc g;
  g.A = (const bf16_t*)A; g.B = (const bf16_t*)B;
  g.lda = lda; g.ldb = ldb; g.M = M; g.N = N; g.K = K; g.nb1 = 1; g.nb2 = 1;
  g.sA1 = g.sA2 = g.sB1 = g.sB2 = 0; g.epi = epi; g.bn64 = 0; g.flag = 0; g.layer = 0;
  g.C = nullptr; g.ldc = 0; g.sC1 = g.sC2 = 0; g.scale = 1.f; g.aux = nullptr;
  return g;
}

__device__ __forceinline__ int get_descs(const Params& p, int gp, int idx, GemmDesc& g) {
  char* ws = p.ws;
  switch (gp) {
    case 0:
      g = mkdesc(ws + OFF_H, 1024, ws + OFF_WT_RET_IN, 1024, T_, 6144, 1024, EPI_RET_IN); g.flag = 256;
      return 1;
    case 1:
      if (idx == 0) {
        g = mkdesc(ws + L0_Q, 1024, ws + L0_K, 1024, 256, 256, 256, EPI_RET_S);
        g.nb1 = 32; g.nb2 = 4; g.sA1 = 256 * 1024; g.sA2 = 256; g.sB1 = 256 * 1024; g.sB2 = 256;
        g.C = (float*)(ws + L0_SP); g.ldc = 256; g.sC1 = 4 * 65536; g.sC2 = 65536;
      } else if (idx == 1) {
        g = mkdesc((bf16_t*)(ws + L0_Q) + (long)TP_ * 1024, 1024, (bf16_t*)(ws + L0_K) + (long)TP_ * 1024, 1024, 1024, 1024, 256, EPI_RET_S);
        g.nb1 = 2; g.nb2 = 4; g.sA1 = 1024 * 1024; g.sA2 = 256; g.sB1 = 1024 * 1024; g.sB2 = 256;
        g.C = (float*)(ws + L0_PEXT); g.ldc = 1536; g.sC1 = 4l * 1024 * 1536; g.sC2 = 1024l * 1536;
      } else {
        int dir = idx - 2;
        g = mkdesc((bf16_t*)(ws + L0_KT) + (long)dir * 32 * 4 * 65536, 256, ws + L0_VTP, 256, 256, 512, 256, EPI_F32);
        g.nb1 = 32; g.nb2 = 4; g.sA1 = 4 * 65536; g.sA2 = 65536; g.sB1 = 4 * 131072; g.sB2 = 131072;
        g.C = p.out + OUT_STATE_RET + (long)dir * 4 * 131072; g.ldc = 512; g.sC1 = 8 * 131072; g.sC2 = 131072; g.flag = 1;
      }
      return 4;
    case 2:
      if (idx == 1) {
        g = mkdesc(ws + L0_SP, 256, ws + L0_VTP, 256, 256, 512, 256, EPI_F32);
        g.nb1 = 32; g.nb2 = 4; g.sA1 = 4 * 65536; g.sA2 = 65536; g.sB1 = 4 * 131072; g.sB2 = 131072;
        g.C = (float*)(ws + L0_O); g.ldc = 2048; g.sC1 = 256 * 2048; g.sC2 = 512; g.flag = 2;
      } else {
        g = mkdesc(ws + L0_PEXT, 1536, ws + L0_VTS, 1536, 1024, 512, 1536, EPI_F32);
        g.nb1 = 2; g.nb2 = 4; g.sA1 = 4l * 1024 * 1536; g.sA2 = 1024l * 1536; g.sB1 = 4l * 512 * 1536; g.sB2 = 512l * 1536;
        g.C = (float*)((bf16_t*)(ws + L0_O) + (long)TP_ * 2048); g.ldc = 2048; g.sC1 = 1024 * 2048; g.sC2 = 512; g.flag = 2;
      }
      return 2;
    case 3:
      g = mkdesc(ws + OFF_OB, 2048, ws + OFF_WT_RET_OUT, 2048, T_, 1024, 2048, EPI_OUT); g.layer = 0; g.flag = 256;
      return 1;
    case 4: {
      if (idx < 4) {
        g = mkdesc(ws + L1_XM + (long)idx * 20 * MIB, 1024, (bf16_t*)(ws + OFF_WT_RWKV_IN) + (long)idx * 1024 * 1024, 1024, T_, 1024, 1024, EPI_BF16);
        g.C = (float*)((bf16_t*)(ws + L1_RKVG) + idx * 1024); g.ldc = 4096;
      } else {
        int w = idx - 4;
        g = mkdesc(ws + L1_XW + (long)w * 20 * MIB, 1024, (bf16_t*)(ws + OFF_WT_LDOWN) + (long)w * 128 * 1024, 1024, T_, 128, 1024, EPI_BF16);
        g.C = (float*)((bf16_t*)(ws + L1_L) + w * 128); g.ldc = 256; g.flag = (w == 0) ? 1 : 0;
      }
      return 6;
    }
    case 5: {
      int dir = idx >> 1, type = idx & 1;
      g = mkdesc((bf16_t*)(ws + L1_L) + type * 128 + dir * 64, 256, (bf16_t*)(ws + OFF_WT_LUP) + (long)(type * 2 + dir) * 65536, 64, T_, 1024, 64,
                 type ? EPI_LUP_A : EPI_LUP_W);
      g.C = (float*)((bf16_t*)(ws + (type ? L1_AA : L1_DEC)) + (long)dir * T_ * 1024);
      g.aux = (type ? p.in[23] : p.in[20]) + dir * 1024;
      return 4;
    }
    case 6:
      g = mkdesc(ws + OFF_OB, 1024, ws + OFF_WT_RWKV_OUT, 1024, T_, 1024, 1024, EPI_OUT); g.layer = 1; g.flag = 256;
      return 1;
    case 7:
      g = mkdesc(ws + OFF_H, 1024, ws + OFF_WT_DIFF_IN, 1024, T_, 4096, 1024, EPI_DIFF_IN); g.flag = 256;
      return 1;
    case 10:
      g = mkdesc(ws + OFF_OB, 1024, ws + OFF_WT_DIFF_OUT, 1024, T_, 1024, 1024, EPI_OUT); g.layer = 2; g.flag = 256;
      return 1;
    case 11:
      g = mkdesc(ws + OFF_H, 1024, ws + OFF_WT_NA_IN, 1024, T_, 4096, 1024, EPI_NA_IN); g.flag = 256;
      return 1;
    case 14:
      g = mkdesc(ws + OFF_OB, 1024, ws + OFF_WT_NA_OUT, 1024, T_, 1024, 1024, EPI_OUT); g.layer = 3; g.flag = 256;
      return 1;
  }
  return 0;
}

__device__ __forceinline__ void gemm_phase(const Params& p, int gp, char* smem, int vb) {
  GemmDesc g;
  int nd = get_descs(p, gp, 0, g);
  int base = 0;
  int tile = vb;
  for (int d = 0; d < nd; ++d) {
    if (d > 0) get_descs(p, gp, d, g);
    int nt = desc_tiles(g);
    while (tile < base + nt) {
      run_desc_tile(p, g, tile - base, smem);
      tile += gridDim.x;
    }
    base += nt;
  }
}

struct TJob { const float* src; int K, N; bf16_t* dst; int perm; };
__device__ __forceinline__ TJob tjob(const Params& p, int j) {
  char* ws = p.ws;
  TJob t; t.perm = 0;
  switch (j) {
    case 0: t.src = p.in[14]; t.K = 1024; t.N = 6144; t.dst = (bf16_t*)(ws + OFF_WT_RET_IN); t.perm = 1; break;
    case 1: t.src = p.in[17]; t.K = 2048; t.N = 1024; t.dst = (bf16_t*)(ws + OFF_WT_RET_OUT); break;
    case 2: t.src = p.in[19]; t.K = 1024; t.N = 4096; t.dst = (bf16_t*)(ws + OFF_WT_RWKV_IN); break;
    case 3: t.src = p.in[30]; t.K = 1024; t.N = 1024; t.dst = (bf16_t*)(ws + OFF_WT_RWKV_OUT); break;
    case 4: t.src = p.in[31]; t.K = 1024; t.N = 4096; t.dst = (bf16_t*)(ws + OFF_WT_DIFF_IN); t.perm = 2; break;
    case 5: t.src = p.in[34]; t.K = 1024; t.N = 1024; t.dst = (bf16_t*)(ws + OFF_WT_DIFF_OUT); break;
    case 6: t.src = p.in[35]; t.K = 1024; t.N = 4096; t.dst = (bf16_t*)(ws + OFF_WT_NA_IN); break;
    case 7: t.src = p.in[37]; t.K = 1024; t.N = 1024; t.dst = (bf16_t*)(ws + OFF_WT_NA_OUT); break;
    case 8: case 9: t.src = p.in[21] + (j - 8) * 65536; t.K = 1024; t.N = 64; t.dst = (bf16_t*)(ws + OFF_WT_LDOWN) + (long)(j - 8) * 64 * 1024; break;
    case 10: case 11: t.src = p.in[24] + (j - 10) * 65536; t.K = 1024; t.N = 64; t.dst = (bf16_t*)(ws + OFF_WT_LDOWN) + (long)(128 + (j - 10) * 64) * 1024; break;
    case 12: case 13: t.src = p.in[22] + (j - 12) * 65536; t.K = 64; t.N = 1024; t.dst = (bf16_t*)(ws + OFF_WT_LUP) + (long)(j - 12) * 65536; break;
    default: t.src = p.in[25] + (j - 14) * 65536; t.K = 64; t.N = 1024; t.dst = (bf16_t*)(ws + OFF_WT_LUP) + (long)(2 + j - 14) * 65536; break;
  }
  return t;
}

__device__ __forceinline__ void transpose_tile(const TJob& t, int tile, char* smem) {
  float* sm = (float*)smem;
  const int tid = threadIdx.x;
  int tn = t.N >> 6;
  int kt = tile / tn, nt = tile - kt * tn;
  int k0 = kt * 64, n0 = nt * 64;
  __syncthreads();
#pragma unroll
  for (int it = 0; it < 16; ++it) {
    int kk = it * 4 + (tid >> 6), nn = tid & 63;
    int nd = n0 + nn;
    int ns = nd;
    if (t.perm == 1 && nd < 2048) ns = (nd & ~255) + perm_ret(nd & 255);
    else if (t.perm == 2 && nd < 2048) ns = perm_diff(nd);
    sm[kk * 65 + nn] = __builtin_nontemporal_load(t.src + (long)(k0 + kk) * t.N + ns);
  }
  __syncthreads();
#pragma unroll
  for (int it = 0; it < 2; ++it) {
    int gidx = tid + it * 256;
    int n = gidx >> 3, kg = gidx & 7;
    unsigned w[4];
#pragma unroll
    for (int e = 0; e < 4; ++e) w[e] = pack2(sm[(kg * 8 + 2 * e) * 65 + n], sm[(kg * 8 + 2 * e + 1) * 65 + n]);
    *(uint4*)(t.dst + (long)(n0 + n) * t.K + k0 + kg * 8) = make_uint4(w[0], w[1], w[2], w[3]);
  }
}

__device__ __forceinline__ void transposes_subset(const Params& p, char* smem, unsigned mask, int worker, int nworkers) {
  int base = 0, tile = worker;
  for (int j = 0; j < 16; ++j) {
    if (!((mask >> j) & 1u)) continue;
    TJob t = tjob(p, j);
    int nt = (t.K >> 6) * (t.N >> 6);
    while (tile < base + nt) { transpose_tile(t, tile - base, smem); tile += nworkers; }
    base += nt;
  }
  __syncthreads();
}
__device__ __forceinline__ void mod_gemv_items(const Params& p, char* smem, int item_lo, int item_hi, int worker, int nworkers) {
  char* ws = p.ws;
  const int tid = threadIdx.x;

    float* sm = (float*)smem;
    const float* wmod = p.in[11];
    const float* bmod = p.in[12];
    for (int item = item_lo + worker; item < item_hi; item += nworkers) {
      int layer = item / 192, cg16 = item - layer * 192;
      int j0 = cg16 * 16;
      int c4 = tid & 3, r = tid >> 2;
      float acc[3][4];
#pragma unroll
      for (int c = 0; c < 3; ++c)
#pragma unroll
        for (int e = 0; e < 4; ++e) acc[c][e] = 0.f;
      float4 wr[16];
#pragma unroll
      for (int it = 0; it < 16; ++it)
        {
          f32x4 t4 = __builtin_nontemporal_load((const f32x4*)(wmod + ((long)layer * 1024 + r + it * 64) * 3072 + j0 + c4 * 4));
          wr[it] = make_float4(t4[0], t4[1], t4[2], t4[3]);
        }
#pragma unroll
      for (int it = 0; it < 16; ++it) {
        int row = r + it * 64;
        float4 w = wr[it];
        float cv0 = p.in[9][row], cv1 = p.in[8][row], cv2 = p.in[8][1024 + row];
        float s0 = silu_f(cv0), s1 = silu_f(cv1), s2 = silu_f(cv2);
        acc[0][0] += s0 * w.x; acc[0][1] += s0 * w.y; acc[0][2] += s0 * w.z; acc[0][3] += s0 * w.w;
        acc[1][0] += s1 * w.x; acc[1][1] += s1 * w.y; acc[1][2] += s1 * w.z; acc[1][3] += s1 * w.w;
        acc[2][0] += s2 * w.x; acc[2][1] += s2 * w.y; acc[2][2] += s2 * w.z; acc[2][3] += s2 * w.w;
      }
      __syncthreads();
#pragma unroll
      for (int c = 0; c < 3; ++c)
#pragma unroll
        for (int e = 0; e < 4; ++e) sm[tid * 12 + c * 4 + e] = acc[c][e];
      __syncthreads();
      if (tid < 48) {
        int c = tid / 16, col = tid & 15;
        int cc4 = col >> 2, e = col & 3;
        float s = 0.f;
        for (int rr = 0; rr < 64; ++rr) s += sm[(rr * 4 + cc4) * 12 + c * 4 + e];
        ((float*)(ws + OFF_MOD))[((long)layer * 3 + c) * 3072 + j0 + col] = s + bmod[layer * 3072 + j0 + col];
      }
    }
    __syncthreads();
}

__device__ __forceinline__ void prep_phase(const Params& p, char* smem) {
  char* ws = p.ws;
  const int tid = threadIdx.x;
  transposes_subset(p, smem, (gridDim.x == 512) ? 0x0001u : 0xFFFFu, blockIdx.x, gridDim.x);
  __syncthreads();
  mod_gemv_items(p, smem, 0, (gridDim.x == 512) ? 192 : 768, blockIdx.x, gridDim.x);
  const long gtid = (long)blockIdx.x * 256 + tid;
  const long gn = (long)gridDim.x * 256;
  if (gtid < 8) {
    float x = p.in[15][gtid];
    float u = -x;
    ((float*)(ws + OFF_TAB))[gtid] = -(fmaxf(u, 0.f) + log1pf(expf(-fabsf(u))));
  }
  for (long i = gtid; i < 2l * 4 * 512 * 512; i += gn) {
    int col = i & 511; long r = i >> 9; int dv = r & 511; r >>= 9; int h = r & 3; int sb = r >> 2;
    int dir = col >> 8, dkp = col & 255;
    float v = p.in[2][((((long)sb * 2 + dir) * 4 + h) * 256 + perm_ret(dkp)) * 512 + dv];
    ((bf16_t*)(ws + L0_VTS))[((long)(sb * 4 + h) * 512 + dv) * 1536 + 1024 + col] = f2bf(v);
  }
}

__device__ __forceinline__ void diff_cache_prep(const Params& p) {
  char* ws = p.ws;
  const long gtid = (long)blockIdx.x * 256 + threadIdx.x;
  const long gn = (long)gridDim.x * 256;
  for (long i = gtid; i < 2l * 8 * 256 * 128; i += gn) {
    int d = i & 127; long r = i >> 7; int pp = r & 255; r >>= 8; int h = r & 7; int sb = r >> 3;
    float kv = p.in[4][((long)(sb * 8 + h) * 256 + pp) * 128 + perm_diff(d)];
    ((bf16_t*)(ws + L2_KALL))[((long)(sb * 8 + h) * 1280 + 1024 + pp) * 128 + d] = f2bf(kv);
  }
  for (long i = gtid; i < 2l * 8 * 128 * 256; i += gn) {
    int pp = i & 255; long r = i >> 8; int dv = r & 127; r >>= 7; int h = r & 7; int sb = r >> 3;
    float vv = p.in[5][((long)(sb * 8 + h) * 256 + pp) * 128 + dv];
    ((bf16_t*)(ws + L2_VTS))[((long)(sb * 8 + h) * 128 + dv) * 1280 + 1024 + pp] = f2bf(vv);
  }
}

__device__ __forceinline__ void na_cache_prep(const Params& p) {
  char* ws = p.ws;
  const long gtid = (long)blockIdx.x * 256 + threadIdx.x;
  const long gn = (long)gridDim.x * 256;
  for (long i = gtid; i < 2l * 16 * 256 * 64; i += gn) {
    int d = i & 63; long r = i >> 6; int pp = r & 255; r >>= 8; int h = r & 15; int sb = r >> 4;
    float kv = p.in[6][((long)(sb * 16 + h) * 256 + pp) * 64 + d];
    ((bf16_t*)(ws + L2_KALL))[((long)(sb * 16 + h) * 1280 + 1024 + pp) * 64 + d] = f2bf(kv);
  }
  for (long i = gtid; i < 2l * 16 * 64 * 256; i += gn) {
    int pp = i & 255; long r = i >> 8; int dv = r & 63; r >>= 6; int h = r & 15; int sb = r >> 4;
    float vv = p.in[7][((long)(sb * 16 + h) * 256 + pp) * 64 + dv];
    ((bf16_t*)(ws + L2_VTS))[((long)(sb * 16 + h) * 64 + dv) * 1280 + 1024 + pp] = f2bf(vv);
  }
}

__device__ __forceinline__ const float* xrow(const Params& p, int layer, int t) {
  if (layer == 0) return (t < TP_) ? p.in[0] + (long)t * 1024 : p.in[1] + (long)(t - TP_) * 1024;
  return p.out + (long)t * 1024;
}
struct F16 { float4 v[4]; };
__device__ __forceinline__ F16 norm_row(const Params& p, int layer, int t, int lane) {
  const float* x = xrow(p, layer, t);
  F16 h;
  float ss = 0.f;
#pragma unroll
  for (int it = 0; it < 4; ++it) {
    float4 v = *(const float4*)(x + it * 256 + lane * 4);
    h.v[it] = v;
    ss += v.x * v.x + v.y * v.y + v.z * v.z + v.w * v.w;
  }
  ss = wave_sum(ss);
  float rinv = rsqrtf(ss * (1.f / 1024.f) + 1e-6f);
  int cond = (t < TP_) ? 0 : 1 + ((t - TP_) >> 10);
  const float* mod = (const float*)(p.ws + OFF_MOD) + ((long)layer * 3 + cond) * 3072;
  const float* nw = p.in[10] + layer * 1024;
#pragma unroll
  for (int it = 0; it < 4; ++it) {
    int c = it * 256 + lane * 4;
    float4 w = *(const float4*)(nw + c);
    float4 sh = *(const float4*)(mod + c);
    float4 sc = *(const float4*)(mod + 1024 + c);
    h.v[it].x = h.v[it].x * rinv * w.x * (1.f + sc.x) + sh.x;
    h.v[it].y = h.v[it].y * rinv * w.y * (1.f + sc.y) + sh.y;
    h.v[it].z = h.v[it].z * rinv * w.z * (1.f + sc.z) + sh.z;
    h.v[it].w = h.v[it].w * rinv * w.w * (1.f + sc.w) + sh.w;
  }
  return h;
}
__device__ __forceinline__ void norm_phase(const Params& p, int layer) {
  const int lane = threadIdx.x & 63;
  const int gw = blockIdx.x * 4 + (threadIdx.x >> 6), nw = gridDim.x * 4;
  bf16_t* H = (bf16_t*)(p.ws + OFF_H);
  if (layer != 1) {
    for (int t = gw; t < T_; t += nw) {
      F16 h = norm_row(p, layer, t, lane);
#pragma unroll
      for (int it = 0; it < 4; ++it)
        *(uint2*)(H + (long)t * 1024 + it * 256 + lane * 4) = make_uint2(pack2(h.v[it].x, h.v[it].y), pack2(h.v[it].z, h.v[it].w));
    }
  } else {
    const float* mu = p.in[18];
    for (int chunk = gw; chunk < T_ / 4; chunk += nw) {
      const int t0 = chunk * 4;
      const int L = (t0 < TP_) ? 256 : 1024;
      const int l0 = (t0 < TP_) ? (t0 & 255) : ((t0 - TP_) & 1023);
      const bool hasp = l0 > 0, hasn = (l0 + 4 < L);
      float rinv[6];
#pragma unroll
      for (int j = 0; j < 6; ++j) {
        const bool ok = (j == 0) ? hasp : ((j == 5) ? hasn : true);
        const float* x = xrow(p, layer, ok ? (t0 - 1 + j) : t0);
        float ss = 0.f;
#pragma unroll
        for (int it = 0; it < 4; ++it) {
          const float4 v = *(const float4*)(x + it * 256 + lane * 4);
          ss += v.x * v.x + v.y * v.y + v.z * v.z + v.w * v.w;
        }
        rinv[j] = ok ? rsqrtf(wave_sum(ss) * (1.f / 1024.f) + 1e-6f) : 0.f;
      }
      const int cond = (t0 < TP_) ? 0 : 1 + ((t0 - TP_) >> 10);
      const float* mod = (const float*)(p.ws + OFF_MOD) + ((long)layer * 3 + cond) * 3072;
      const float* nwp = p.in[10] + layer * 1024;
#pragma unroll
      for (int it = 0; it < 4; ++it) {
        const int c = it * 256 + lane * 4;
        const float4 w = *(const float4*)(nwp + c);
        const float4 sh = *(const float4*)(mod + c);
        const float4 sc = *(const float4*)(mod + 1024 + c);
        const float4 ws4 = make_float4(w.x * (1.f + sc.x), w.y * (1.f + sc.y), w.z * (1.f + sc.z), w.w * (1.f + sc.w));
        float4 hr0, hr1, hr2, hr3, hr4, hr5;
#define NROW(dst, j)                                                                            \
        {                                                                                       \
          const bool ok = ((j) == 0) ? hasp : (((j) == 5) ? hasn : true);                        \
          const float4 v = *(const float4*)(xrow(p, layer, ok ? (t0 - 1 + (j)) : t0) + c);       \
          const float ri = rinv[j];                                                              \
          dst = ok ? make_float4(v.x * ri * ws4.x + sh.x, v.y * ri * ws4.y + sh.y, v.z * ri * ws4.z + sh.z, v.w * ri * ws4.w + sh.w) \
                   : make_float4(0.f, 0.f, 0.f, 0.f);                                            \
        }
        NROW(hr0, 0) NROW(hr1, 1) NROW(hr2, 2) NROW(hr3, 3) NROW(hr4, 4) NROW(hr5, 5)
#undef NROW
#define MIX1(ha, hh, hb, j)                                                                      \
          {                                                                                      \
            float x0 = hh.x + (0.5f * (ha.x + hb.x) - hh.x) * m.x;                               \
            float x1 = hh.y + (0.5f * (ha.y + hb.y) - hh.y) * m.y;                               \
            float x2 = hh.z + (0.5f * (ha.z + hb.z) - hh.z) * m.z;                               \
            float x3 = hh.w + (0.5f * (ha.w + hb.w) - hh.w) * m.w;                               \
            *(uint2*)(dst + (long)(t0 + (j)) * 1024 + c) = make_uint2(pack2(x0, x1), pack2(x2, x3)); \
          }
#pragma unroll
        for (int n = 0; n < 6; ++n) {
          bf16_t* dst = (n == 0) ? (bf16_t*)(p.ws + L1_XM) : (n == 2) ? (bf16_t*)(p.ws + L1_XM + 20 * MIB) : (n == 3) ? (bf16_t*)(p.ws + L1_XM + 40 * MIB)
                      : (n == 5) ? (bf16_t*)(p.ws + L1_XM + 60 * MIB) : (n == 1) ? (bf16_t*)(p.ws + L1_XW) : (bf16_t*)(p.ws + L1_XW + 20 * MIB);
          const float4 m = *(const float4*)(mu + n * 1024 + c);
          MIX1(hr0, hr1, hr2, 0)
          MIX1(hr1, hr2, hr3, 1)
          MIX1(hr2, hr3, hr4, 2)
          MIX1(hr3, hr4, hr5, 3)
        }
#undef MIX1
      }
    }
  }
}

__device__ __forceinline__ void final_norm_phase(const Params& p) {
  const int lane = threadIdx.x & 63;
  const int gw = blockIdx.x * 4 + (threadIdx.x >> 6), nw = gridDim.x * 4;
  const float* fw = p.in[13];
  for (int t = gw; t < T_; t += nw) {
    float* x = p.out + (long)t * 1024;
    float4 v[4];
    float ss = 0.f;
#pragma unroll
    for (int it = 0; it < 4; ++it) {
      v[it] = *(const float4*)(x + it * 256 + lane * 4);
      ss += v[it].x * v[it].x + v[it].y * v[it].y + v[it].z * v[it].z + v[it].w * v[it].w;
    }
    ss = wave_sum(ss);
    float rinv = rsqrtf(ss * (1.f / 1024.f) + 1e-6f);
#pragma unroll
    for (int it = 0; it < 4; ++it) {
      float4 w = *(const float4*)(fw + it * 256 + lane * 4);
      nt_store4(x + it * 256 + lane * 4, v[it].x * rinv * w.x, v[it].y * rinv * w.y, v[it].z * rinv * w.z, v[it].w * rinv * w.w);
    }
  }
}

__device__ __forceinline__ void ret_ln_phase(const Params& p) {
  const int lane = threadIdx.x & 63;
  const int gw = blockIdx.x * 4 + (threadIdx.x >> 6), nw = gridDim.x * 4;
  const bf16_t* O = (const bf16_t*)(p.ws + L0_O);
  const bf16_t* G = (const bf16_t*)(p.ws + L0_G);
  bf16_t* OB = (bf16_t*)(p.ws + OFF_OB);
  const float* gn = p.in[16];
  for (int item = gw; item < T_ * 4; item += nw) {
    long base = (long)item * 512 + lane * 8;
    const uint4 oh = *(const uint4*)(O + base);
    float4 a = make_float4(bf2f(oh.x & 0xffff), bf2f(oh.x >> 16), bf2f(oh.y & 0xffff), bf2f(oh.y >> 16));
    float4 b = make_float4(bf2f(oh.z & 0xffff), bf2f(oh.z >> 16), bf2f(oh.w & 0xffff), bf2f(oh.w >> 16));
    float s = a.x + a.y + a.z + a.w + b.x + b.y + b.z + b.w;
    float mean = wave_sum(s) * (1.f / 512.f);
    a.x -= mean; a.y -= mean; a.z -= mean; a.w -= mean; b.x -= mean; b.y -= mean; b.z -= mean; b.w -= mean;
    float vs = a.x * a.x + a.y * a.y + a.z * a.z + a.w * a.w + b.x * b.x + b.y * b.y + b.z * b.z + b.w * b.w;
    float rinv = rsqrtf(wave_sum(vs) * (1.f / 512.f) + 1e-5f);
    int col = (item & 3) * 512 + lane * 8;
    uint4 gg = *(const uint4*)(G + base);
    float4 w0 = *(const float4*)(gn + col), w1 = *(const float4*)(gn + col + 4);
    uint4 o;
    o.x = pack2(a.x * rinv * w0.x * silu_f(bf2f(gg.x & 0xffff)), a.y * rinv * w0.y * silu_f(bf2f(gg.x >> 16)));
    o.y = pack2(a.z * rinv * w0.z * silu_f(bf2f(gg.y & 0xffff)), a.w * rinv * w0.w * silu_f(bf2f(gg.y >> 16)));
    o.z = pack2(b.x * rinv * w1.x * silu_f(bf2f(gg.z & 0xffff)), b.y * rinv * w1.y * silu_f(bf2f(gg.z >> 16)));
    o.w = pack2(b.z * rinv * w1.z * silu_f(bf2f(gg.w & 0xffff)), b.w * rinv * w1.w * silu_f(bf2f(gg.w >> 16)));
    *(uint4*)(OB + base) = o;
  }
}

__device__ __forceinline__ float dpp_xor1(float x) {
  return __builtin_bit_cast(float, __builtin_amdgcn_mov_dpp(__builtin_bit_cast(int, x), 0xB1, 0xF, 0xF, true));
}
__device__ __forceinline__ float dpp_xor2(float x) {
  return __builtin_bit_cast(float, __builtin_amdgcn_mov_dpp(__builtin_bit_cast(int, x), 0x4E, 0xF, 0xF, true));
}
__device__ __forceinline__ float dpp_hmirror(float x) {
  return __builtin_bit_cast(float, __builtin_amdgcn_mov_dpp(__builtin_bit_cast(int, x), 0x141, 0xF, 0xF, true));
}
__device__ __forceinline__ float red8(float x) {
  x += dpp_xor1(x);
  x += dpp_xor2(x);
  x += dpp_hmirror(x);
  return x;
}
template <int R>
__device__ __forceinline__ void rwkv_scan_item(const Params& p, int sample, int bb, int h, int dir, int half, char* smem) {
  char* ws = p.ws;
  float* sm = (float*)smem;
  const int tid = threadIdx.x;
  int L = sample ? 1024 : 256;
  int tok0 = sample ? TP_ + bb * 1024 : bb * 256;
  const int rp = tid >> 3, kq = tid & 7;
  const int row0 = (R == 2) ? 2 * rp : half * 32 + rp;
  v2f P[8];
#pragma unroll
  for (int i = 0; i < 8; ++i) P[i] = (v2f)(0.f);
  if (sample) {
    const float* s0 = p.in[3] + (((long)(bb * 2 + dir) * 16 + h) * 64 + row0) * 64 + kq * 8;
    if (R == 2) {
#pragma unroll
      for (int i = 0; i < 8; ++i) { P[i].x = s0[i]; P[i].y = s0[64 + i]; }
    } else {
#pragma unroll
      for (int j = 0; j < 4; ++j) { P[j].x = s0[2 * j]; P[j].y = s0[2 * j + 1]; }
    }
  }
  const bf16_t* RKVG = (const bf16_t*)(ws + L1_RKVG);
  const bf16_t* DEC = (const bf16_t*)(ws + L1_DEC) + (long)dir * T_ * 1024;
  const bf16_t* AA = (const bf16_t*)(ws + L1_AA) + (long)dir * T_ * 1024;
  float* Y = (float*)(ws + L1_Y) + (long)dir * T_ * 1024;
  const int ch = tid & 63, col = h * 64 + ch, sw = tid >> 6;
  const float kkw = p.in[26][col];
  const float kaw = p.in[27][col];
  const int nch = L >> 4;
  float rr[4], rk[4], rv[4], rwd[4], ra[4];
#define SCAN_LOAD(c)                                                        \
  _Pragma("unroll") for (int i = 0; i < 4; ++i) {                           \
    int pos = (c) * 16 + sw + i * 4;                                        \
    int t = dir ? (L - 1 - pos) : pos;                                      \
    long tok = tok0 + t;                                                    \
    rr[i] = bf2f(RKVG[tok * 4096 + col]);                                   \
    rk[i] = bf2f(RKVG[tok * 4096 + 1024 + col]);                            \
    rv[i] = bf2f(RKVG[tok * 4096 + 2048 + col]);                            \
    rwd[i] = __expf(-bf2f(DEC[tok * 1024 + col]));                          \
    ra[i] = bf2f(AA[tok * 1024 + col]);                                     \
  }
#define SCAN_PREP(buf)                                                      \
  _Pragma("unroll") for (int i = 0; i < 4; ++i) {                           \
    float* b = sm + (buf) * 6144 + (sw + i * 4) * 64 + ch;                  \
    float kkr = rk[i] * kkw;                                                \
    float ss = wave_sum(kkr * kkr);                                         \
    float kk = kkr * rsqrtf(fmaxf(ss, 1e-12f));                             \
    b[0] = rr[i]; b[1024] = rwd[i]; b[2048] = kk; b[3072] = kk * ra[i];     \
    b[4096] = rk[i] * (1.f + (ra[i] - 1.f) * kaw); b[5120] = rv[i];         \
  }
#define YFLUSH(cc)                                                                   \
  {                                                                                  \
    constexpr int QPR = (R == 2) ? 16 : 8;                     \
    if (tid < 16 * QPR) {                                                            \
      const int s_ = tid / QPR, q_ = tid - s_ * QPR;                                 \
      const int pos_ = (cc) * 16 + s_;                                               \
      const int t_ = dir ? (L - 1 - pos_) : pos_;                                    \
      const float4 yv = *(const float4*)(sm + 12288 + ((cc) & 1) * 1024 + s_ * 64 + q_ * 4); \
      *(float4*)(Y + (long)(tok0 + t_) * 1024 + h * 64 + ((R == 2) ? 0 : half * 32) + q_ * 4) = yv; \
    }                                                                                \
  }
  __syncthreads();
  SCAN_LOAD(0)
  SCAN_PREP(0)
  for (int c = 0; c < nch; ++c) {
    const int buf = c & 1;
    if (c + 1 < nch) SCAN_LOAD(c + 1)
    __syncthreads();
    if (c > 0) YFLUSH(c - 1)
    const float* bs = sm + buf * 6144;
    float4 n_kk0, n_kk1, n_w0, n_w1, n_ka0, n_ka1, n_kd0, n_kd1, n_r0, n_r1; float n_vx, n_vy = 0.f;
#define STEP_LOAD(s)                                                              \
    {                                                                             \
      const float* o = bs + (s) * 64 + kq * 8;                                    \
      n_kk0 = *(const float4*)(o + 2048); n_kk1 = *(const float4*)(o + 2052);     \
      n_w0 = *(const float4*)(o + 1024); n_w1 = *(const float4*)(o + 1028);       \
      n_ka0 = *(const float4*)(o + 3072); n_ka1 = *(const float4*)(o + 3076);     \
      n_kd0 = *(const float4*)(o + 4096); n_kd1 = *(const float4*)(o + 4100);     \
      n_r0 = *(const float4*)(o); n_r1 = *(const float4*)(o + 4);                 \
      if (R == 2) { const float2 vv = *(const float2*)(bs + 5120 + (s) * 64 + row0); n_vx = vv.x; n_vy = vv.y; } \
      else n_vx = bs[5120 + (s) * 64 + row0];                                     \
    }
    STEP_LOAD(0)
#pragma unroll
    for (int s = 0; s < 16; ++s) {
      const float4 kka = n_kk0, kkb = n_kk1, wa = n_w0, wb = n_w1, ka = n_ka0, kb = n_ka1, da = n_kd0, db = n_kd1, ra4 = n_r0, rb4 = n_r1;
      const float vx = n_vx, vy = n_vy;
      if (s + 1 < 16) STEP_LOAD(s + 1)
      const float kkv[8] = {kka.x, kka.y, kka.z, kka.w, kkb.x, kkb.y, kkb.z, kkb.w};
      const float wv[8] = {wa.x, wa.y, wa.z, wa.w, wb.x, wb.y, wb.z, wb.w};
      const float kv[8] = {ka.x, ka.y, ka.z, ka.w, kb.x, kb.y, kb.z, kb.w};
      const float dv[8] = {da.x, da.y, da.z, da.w, db.x, db.y, db.z, db.w};
      const float rv8[8] = {ra4.x, ra4.y, ra4.z, ra4.w, rb4.x, rb4.y, rb4.z, rb4.w};
      float y0, y1 = 0.f;
      if (R == 2) {
        v2f dA = P[0] * (v2f)(kkv[0]), dB = P[1] * (v2f)(kkv[1]);
#pragma unroll
        for (int i = 2; i < 8; i += 2) { dA += P[i] * (v2f)(kkv[i]); dB += P[i + 1] * (v2f)(kkv[i + 1]); }
        const v2f d = dA + dB;
        v2f sa; sa.x = -red8(d.x); sa.y = -red8(d.y);
        v2f vv; vv.x = vx; vv.y = vy;
        v2f yA = (v2f)(0.f), yB = (v2f)(0.f);
#pragma unroll
        for (int i = 0; i < 8; i += 2) {
          P[i] = P[i] * (v2f)(wv[i]) + (sa * (v2f)(kv[i]) + vv * (v2f)(dv[i]));
          P[i + 1] = P[i + 1] * (v2f)(wv[i + 1]) + (sa * (v2f)(kv[i + 1]) + vv * (v2f)(dv[i + 1]));
          yA += P[i] * (v2f)(rv8[i]); yB += P[i + 1] * (v2f)(rv8[i + 1]);
        }
        const v2f yy = yA + yB;
        y0 = red8(yy.x); y1 = red8(yy.y);
      } else {
        v2f dA = P[0] * (v2f){kkv[0], kkv[1]} + P[2] * (v2f){kkv[4], kkv[5]};
        v2f dB = P[1] * (v2f){kkv[2], kkv[3]} + P[3] * (v2f){kkv[6], kkv[7]};
        const v2f d = dA + dB;
        const float sa = -red8(d.x + d.y);
        v2f yA = (v2f)(0.f), yB = (v2f)(0.f);
#pragma unroll
        for (int j = 0; j < 4; j += 2) {
          P[j] = P[j] * (v2f){wv[2 * j], wv[2 * j + 1]} + ((v2f)(sa) * (v2f){kv[2 * j], kv[2 * j + 1]} + (v2f)(vx) * (v2f){dv[2 * j], dv[2 * j + 1]});
          P[j + 1] = P[j + 1] * (v2f){wv[2 * j + 2], wv[2 * j + 3]} + ((v2f)(sa) * (v2f){kv[2 * j + 2], kv[2 * j + 3]} + (v2f)(vx) * (v2f){dv[2 * j + 2], dv[2 * j + 3]});
          yA += P[j] * (v2f){rv8[2 * j], rv8[2 * j + 1]}; yB += P[j + 1] * (v2f){rv8[2 * j + 2], rv8[2 * j + 3]};
        }
        const v2f yy = yA + yB;
        y0 = red8(yy.x + yy.y);
      }
      if (kq == 0) {
        float* yb = sm + 12288 + buf * 1024 + s * 64 + ((R == 2) ? 2 * rp : rp);
        if (R == 2) *(float2*)yb = make_float2(y0, y1);
        else *yb = y0;
      }
    }
#undef STEP_LOAD
    if (c + 1 < nch) SCAN_PREP(buf ^ 1)
  }
  __syncthreads();
  YFLUSH(nch - 1)
#undef YFLUSH
#undef SCAN_LOAD
#undef SCAN_PREP
  if (!sample) {
    float* so = p.out + OUT_STATE_RWKV + (((long)(bb * 2 + dir) * 16 + h) * 64 + row0) * 64 + kq * 8;
    if (R == 2) {
      nt_store4(so, P[0].x, P[1].x, P[2].x, P[3].x);
      nt_store4(so + 4, P[4].x, P[5].x, P[6].x, P[7].x);
      nt_store4(so + 64, P[0].y, P[1].y, P[2].y, P[3].y);
      nt_store4(so + 68, P[4].y, P[5].y, P[6].y, P[7].y);
    } else {
      *(float4*)(so) = make_float4(P[0].x, P[0].y, P[1].x, P[1].y);
      *(float4*)(so + 4) = make_float4(P[2].x, P[2].y, P[3].x, P[3].y);
    }
  }
}
__device__ __forceinline__ void deferred_transposes(const Params& p, char* smem, int worker, int nworkers) {
  int base = 0, tile = worker;
  for (int j = 4; j <= 7; ++j) {
    TJob t = tjob(p, j);
    int nt = (t.K >> 6) * (t.N >> 6);
    while (tile < base + nt) { transpose_tile(t, tile - base, smem); tile += nworkers; }
    base += nt;
  }
  __syncthreads();
}
__device__ __forceinline__ void rwkv_scan_phase(const Params& p, char* smem) {
  const int nb = gridDim.x, b = blockIdx.x;
  if (nb == 512) {
    if (b < 128) { int sc = b >> 1; rwkv_scan_item<1>(p, 1, sc >> 5, (sc >> 1) & 15, sc & 1, b & 1, smem); }
    else
      for (int it = b - 128; it < 1024; it += nb - 128) rwkv_scan_item<2>(p, 0, it >> 5, (it >> 1) & 15, it & 1, 0, smem);
    if (b < 128) { deferred_transposes(p, smem, b, 256); mod_gemv_items(p, smem, 384, 768, b, 256); }
    else if (b >= 384) { deferred_transposes(p, smem, 128 + (b - 384), 256); mod_gemv_items(p, smem, 384, 768, 128 + (b - 384), 256); }
  } else if (nb >= 256) {
    if (b < 128) { int sc = b >> 1; rwkv_scan_item<1>(p, 1, sc >> 5, (sc >> 1) & 15, sc & 1, b & 1, smem); }
    else
      for (int it = b - 128; it < 1024; it += nb - 128) rwkv_scan_item<2>(p, 0, it >> 5, (it >> 1) & 15, it & 1, 0, smem);
  } else {
    for (int it = b; it < 1088; it += nb) {
      if (it < 64) rwkv_scan_item<2>(p, 1, it >> 5, (it >> 1) & 15, it & 1, 0, smem);
      else { int i2 = it - 64; rwkv_scan_item<2>(p, 0, i2 >> 5, (i2 >> 1) & 15, i2 & 1, 0, smem); }
    }
  }
}
__device__ __forceinline__ float row_sum(float v) {
  v += DPPF(v, 0xB1);
  v += DPPF(v, 0x4E);
  v += DPPF(v, 0x141);
  v += DPPF(v, 0x140);
  return v;
}
__device__ __forceinline__ void rwkv_post_phase(const Params& p) {
  char* ws = p.ws;
  const int lane = threadIdx.x & 63;
  const int gw = blockIdx.x * 4 + (threadIdx.x >> 6), nw = gridDim.x * 4;
  const bf16_t* RKVG = (const bf16_t*)(ws + L1_RKVG);
  const bf16_t* AA = (const bf16_t*)(ws + L1_AA);
  const float* Y = (const float*)(ws + L1_Y);
  bf16_t* OB = (bf16_t*)(ws + OFF_OB);
  for (int item = gw; item < T_ * 4; item += nw) {
    const long t = item >> 2;
    const int c0 = (item & 3) * 256 + lane * 4;
    const uint2 r2 = *(const uint2*)(RKVG + t * 4096 + c0);
    const uint2 k2 = *(const uint2*)(RKVG + t * 4096 + 1024 + c0);
    const uint2 v2 = *(const uint2*)(RKVG + t * 4096 + 2048 + c0);
    const uint2 g2 = *(const uint2*)(RKVG + t * 4096 + 3072 + c0);
    const uint2 a0h = *(const uint2*)(AA + t * 1024 + c0);
    const uint2 a1h = *(const uint2*)(AA + (long)T_ * 1024 + t * 1024 + c0);
    const float4 y0 = *(const float4*)(Y + t * 1024 + c0);
    const float4 y1 = *(const float4*)(Y + (long)T_ * 1024 + t * 1024 + c0);
    const float4 ka = *(const float4*)(p.in[27] + c0);
    const float4 rk = *(const float4*)(p.in[28] + c0);
    const float4 gn = *(const float4*)(p.in[29] + c0);
    const float r[4] = {bf2f(r2.x & 0xffff), bf2f(r2.x >> 16), bf2f(r2.y & 0xffff), bf2f(r2.y >> 16)};
    const float k[4] = {bf2f(k2.x & 0xffff), bf2f(k2.x >> 16), bf2f(k2.y & 0xffff), bf2f(k2.y >> 16)};
    const float v[4] = {bf2f(v2.x & 0xffff), bf2f(v2.x >> 16), bf2f(v2.y & 0xffff), bf2f(v2.y >> 16)};
    const float g[4] = {bf2f(g2.x & 0xffff), bf2f(g2.x >> 16), bf2f(g2.y & 0xffff), bf2f(g2.y >> 16)};
    const float as[4] = {bf2f(a0h.x & 0xffff) + bf2f(a1h.x & 0xffff), bf2f(a0h.x >> 16) + bf2f(a1h.x >> 16),
                         bf2f(a0h.y & 0xffff) + bf2f(a1h.y & 0xffff), bf2f(a0h.y >> 16) + bf2f(a1h.y >> 16)};
    const float kav[4] = {ka.x, ka.y, ka.z, ka.w};
    const float rkv[4] = {rk.x, rk.y, rk.z, rk.w};
    const float gnv[4] = {gn.x, gn.y, gn.z, gn.w};
    float y[4] = {y0.x + y1.x, y0.y + y1.y, y0.z + y1.z, y0.w + y1.w};
    float bs = 0.f, ys = 0.f;
#pragma unroll
    for (int e = 0; e < 4; ++e) {
      bs += r[e] * (k[e] * (2.f + (as[e] - 2.f) * kav[e])) * rkv[e];
      ys += y[e];
    }
    const float bsum = row_sum(bs);
    const float mean = row_sum(ys) * (1.f / 64.f);
    float vs = 0.f;
#pragma unroll
    for (int e = 0; e < 4; ++e) { y[e] -= mean; vs += y[e] * y[e]; }
    const float rinv = rsqrtf(row_sum(vs) * (1.f / 64.f) + 1e-5f);
    float o[4];
#pragma unroll
    for (int e = 0; e < 4; ++e) o[e] = (y[e] * rinv * gnv[e] + bsum * v[e]) * silu_f(g[e]);
    *(uint2*)(OB + t * 1024 + c0) = make_uint2(pack2(o[0], o[1]), pack2(o[2], o[3]));
  }
}

__device__ __forceinline__ float diff_lambda(const Params& p, int lane, float lam_init) {
  const float* lp = p.in[32];
  float a = wave_sum(lp[lane] * lp[64 + lane]);
  float b = wave_sum(lp[128 + lane] * lp[192 + lane]);
  return __expf(a) - __expf(b) + lam_init;
}
#define LAM_INIT_2 0.47071302f

template <int NC, int DV, bool sample>
__device__ __forceinline__ void attn_item(const Params& p, int seq, int h, int qb, float lam, char* smem) {
  constexpr bool NA = (NC == 1);
  constexpr int KW = NC * 64;
  constexpr int NH = 1024 / KW;
  constexpr int KS = 72;
  constexpr int VS = 72;
  constexpr int NDT = DV / 16;
  constexpr int OSS = DV + 4;
  char* ws = p.ws;
  bf16_t* Ks = (bf16_t*)smem;
  bf16_t* Vs = Ks + 64 * KS;
  float* Os = (float*)(Vs + DV * VS);
  const int tid = threadIdx.x, lane = tid & 63, w = tid >> 6, l15 = lane & 15, q4 = lane >> 4;
  constexpr int Lk = sample ? 1280 : 256;
  const long tok0 = sample ? (long)TP_ + seq * 1024 : (long)seq * 256;
  const long q_tok = tok0 + qb * 64 + w * 16 + l15;
  constexpr int kstride = sample ? KW : 1024;
  const bf16_t* Kb = sample ? (const bf16_t*)(ws + L2_KALL) + (long)(seq * NH + h) * 1280 * KW
                            : (const bf16_t*)(ws + L2_KP) + tok0 * 1024 + h * KW;
  const bf16_t* Vb = sample ? (const bf16_t*)(ws + L2_VTS) + (long)(seq * NH + h) * DV * 1280
                            : (const bf16_t*)(ws + L2_VTP) + (long)(seq * NH + h) * DV * 256;
  const int rs = min(max(qb - 4, 0), 8);
  const int qc = w * 16 + l15;
  const int cs = min(max(qc - 8, 0), 48);
  const float* bt = p.in[36] + h * 465;
  constexpr int ntiles = (NA && sample) ? 12 : (Lk >> 6);
  f32x4 O[NDT];
  float lsum = 0.f;
  bf16x8 qf[2];
  float mrun = -INFINITY, lrun = 0.f;
  constexpr int npass = NC * ntiles;
  uint4 kr0, kr1, vr0, vr1, vr2 = make_uint4(0, 0, 0, 0), vr3 = make_uint4(0, 0, 0, 0);
  const int ldrow = tid >> 3, ldch = tid & 7;
#define ATT_LOAD(pi)                                                                                   \
  {                                                                                                    \
    const int c_ = (pi) / ntiles, ti_ = (pi) - c_ * ntiles;                                            \
    const int kt_ = (NA && sample) ? (ti_ < 8 ? rs + ti_ : 8 + ti_) : ti_;                             \
    const int key0_ = kt_ * 64;                                                                        \
    kr0 = *(const uint4*)(Kb + (long)(key0_ + ldrow) * kstride + c_ * 64 + ldch * 8);                  \
    kr1 = *(const uint4*)(Kb + (long)(key0_ + ldrow + 32) * kstride + c_ * 64 + ldch * 8);             \
    vr0 = *(const uint4*)(Vb + (long)ldrow * Lk + key0_ + ldch * 8);                                   \
    vr1 = *(const uint4*)(Vb + (long)(ldrow + 32) * Lk + key0_ + ldch * 8);                            \
    if (DV > 64) {                                                                                     \
      vr2 = *(const uint4*)(Vb + (long)(ldrow + 64) * Lk + key0_ + ldch * 8);                          \
      vr3 = *(const uint4*)(Vb + (long)(ldrow + 96) * Lk + key0_ + ldch * 8);                          \
    }                                                                                                  \
  }
  ATT_LOAD(0)
#pragma unroll 1
  for (int pi = 0; pi < npass; ++pi) {
    const int c = pi / ntiles, ti = pi - c * ntiles;
    if (ti == 0) {
      const bf16_t* Q = (const bf16_t*)(ws + L2_Q) + q_tok * 1024 + h * KW + c * 64;
      qf[0] = *(const bf16x8*)(Q + q4 * 8);
      qf[1] = *(const bf16x8*)(Q + 32 + q4 * 8);
      mrun = -INFINITY; lrun = 0.f;
#pragma unroll
      for (int dt = 0; dt < NDT; ++dt) O[dt] = (f32x4){0.f, 0.f, 0.f, 0.f};
    }
    const int kt = (NA && sample) ? (ti < 8 ? rs + ti : 8 + ti) : ti;
    __syncthreads();
    *(uint4*)(Ks + ldrow * KS + ldch * 8) = kr0;
    *(uint4*)(Ks + (ldrow + 32) * KS + ldch * 8) = kr1;
    *(uint4*)(Vs + ldrow * VS + ldch * 8) = vr0;
    *(uint4*)(Vs + (ldrow + 32) * VS + ldch * 8) = vr1;
    if (DV > 64) {
      *(uint4*)(Vs + (ldrow + 64) * VS + ldch * 8) = vr2;
      *(uint4*)(Vs + (ldrow + 96) * VS + ldch * 8) = vr3;
    }
    __syncthreads();
    if (pi + 1 < npass) ATT_LOAD(pi + 1)
    {
      f32x4 s[4];
#pragma unroll
      for (int st = 0; st < 4; ++st) {
        s[st] = (f32x4){0.f, 0.f, 0.f, 0.f};
#pragma unroll
        for (int ks = 0; ks < 2; ++ks) {
          bf16x8 a = *(const bf16x8*)(Ks + (st * 16 + l15) * KS + ks * 32 + q4 * 8);
          s[st] = __builtin_amdgcn_mfma_f32_16x16x32_f16(a, qf[ks], s[st], 0, 0, 0);
        }
      }
      float mx = -INFINITY;
#pragma unroll
      for (int st = 0; st < 4; ++st)
#pragma unroll
        for (int j = 0; j < 4; ++j) {
          float val = s[st][j] * 0.125f;
          if (NA && sample && kt < 16) {
            int kc = st * 16 + q4 * 4 + j;
            bool ok = (kc >= cs) && (kc < cs + 16);
            int ro = kt - qb + 7;
            int co = min(max(kc - qc, -15), 15) + 15;
            val = ok ? val + bt[ro * 31 + co] : -INFINITY;
          }
          s[st][j] = val;
          mx = fmaxf(mx, val);
        }
      mx = fmaxf(mx, __shfl_xor(mx, 16));
      mx = fmaxf(mx, __shfl_xor(mx, 32));
      const float mnew = fmaxf(mrun, mx);
      const float alpha = __expf(mrun - mnew);
      mrun = mnew;
      float psum = 0.f;
#pragma unroll
      for (int st = 0; st < 4; ++st)
#pragma unroll
        for (int j = 0; j < 4; ++j) {
          float pv = __expf(s[st][j] - mnew);
          s[st][j] = pv;
          psum += pv;
        }
      lrun = lrun * alpha + psum;
#pragma unroll
      for (int dt = 0; dt < NDT; ++dt) {
        O[dt][0] *= alpha; O[dt][1] *= alpha; O[dt][2] *= alpha; O[dt][3] *= alpha;
      }
#pragma unroll
      for (int pp = 0; pp < 2; ++pp) {
        bf16x8 pf;
#pragma unroll
        for (int j = 0; j < 4; ++j) { pf[j] = (_Float16)s[2 * pp][j]; pf[4 + j] = (_Float16)s[2 * pp + 1][j]; }
#pragma unroll
        for (int dt = 0; dt < NDT; ++dt) {
          const bf16_t* vr = Vs + (dt * 16 + l15) * VS + pp * 32 + q4 * 4;
          uint2 lo = *(const uint2*)vr, hi = *(const uint2*)(vr + 16);
          uint4 av = make_uint4(lo.x, lo.y, hi.x, hi.y);
          O[dt] = __builtin_amdgcn_mfma_f32_16x16x32_f16(__builtin_bit_cast(bf16x8, av), pf, O[dt], 0, 0, 0);
        }
      }
    }
    if (ti == ntiles - 1) {
      lrun += __shfl_xor(lrun, 16);
      lrun += __shfl_xor(lrun, 32);
      lsum = lrun;
      if (!NA && c == 0) {
        const float il = __builtin_amdgcn_rcpf(lrun);
        float* os = Os + (w * 16 + l15) * OSS + q4 * 4;
#pragma unroll
        for (int dt = 0; dt < NDT; ++dt)
          *(float4*)(os + dt * 16) = make_float4(O[dt][0] * il, O[dt][1] * il, O[dt][2] * il, O[dt][3] * il);
      }
    }
  }
#undef ATT_LOAD
  const bf16_t* G = (const bf16_t*)(ws + L2_G) + q_tok * 1024 + h * DV;
  bf16_t* OB = (bf16_t*)(ws + OFF_OB) + q_tok * 1024 + h * DV;
  if (NA) {
    const float il = __builtin_amdgcn_rcpf(lsum);
#pragma unroll
    for (int dt = 0; dt < NDT; ++dt) {
      int dv = dt * 16 + q4 * 4;
      uint2 gg = *(const uint2*)(G + dv);
      float g0 = bf2f(gg.x & 0xffff), g1 = bf2f(gg.x >> 16), g2 = bf2f(gg.y & 0xffff), g3 = bf2f(gg.y >> 16);
      *(uint2*)(OB + dv) = make_uint2(pack2(O[dt][0] * il * silu_f(g0), O[dt][1] * il * silu_f(g1)),
                                      pack2(O[dt][2] * il * silu_f(g2), O[dt][3] * il * silu_f(g3)));
    }
  } else {
    const float i1 = lam * __builtin_amdgcn_rcpf(lsum);
    const float* os = Os + (w * 16 + l15) * OSS + q4 * 4;
    float ss = 0.f;
#pragma unroll
    for (int dt = 0; dt < NDT; ++dt) {
      float4 o0 = *(const float4*)(os + dt * 16);
      O[dt][0] = o0.x - O[dt][0] * i1; O[dt][1] = o0.y - O[dt][1] * i1;
      O[dt][2] = o0.z - O[dt][2] * i1; O[dt][3] = o0.w - O[dt][3] * i1;
      ss += O[dt][0] * O[dt][0] + O[dt][1] * O[dt][1] + O[dt][2] * O[dt][2] + O[dt][3] * O[dt][3];
    }
    ss += __shfl_xor(ss, 16);
    ss += __shfl_xor(ss, 32);
    const float rinv = rsqrtf(ss * (1.f / DV) + 1e-6f) * (1.f - LAM_INIT_2);
    const float* gn = p.in[33] + h * DV;
#pragma unroll
    for (int dt = 0; dt < NDT; ++dt) {
      int dv = dt * 16 + q4 * 4;
      uint2 gg = *(const uint2*)(G + dv);
      float4 gw = *(const float4*)(gn + dv);
      float g0 = bf2f(gg.x & 0xffff), g1 = bf2f(gg.x >> 16), g2 = bf2f(gg.y & 0xffff), g3 = bf2f(gg.y >> 16);
      *(uint2*)(OB + dv) = make_uint2(pack2(O[dt][0] * rinv * gw.x * silu_f(g0), O[dt][1] * rinv * gw.y * silu_f(g1)),
                                      pack2(O[dt][2] * rinv * gw.z * silu_f(g2), O[dt][3] * rinv * gw.w * silu_f(g3)));
    }
  }
}
__device__ __forceinline__ void diff_attn_phase(const Params& p, char* smem) {
  const int lane = threadIdx.x & 63;
  const float lam = diff_lambda(p, lane, LAM_INIT_2);
  const int b = blockIdx.x, nb = gridDim.x;
  const bool split = nb >= 512;
  int it = split ? (b < 256 ? b : 256 + (b - 256)) : b;
  const int step = split ? (b < 256 ? 1 << 30 : nb - 256) : nb;
  for (; it < 1280; it += step) {
    bool sample = it < 256;
    int i2 = sample ? it : it - 256;
    int seq = sample ? (i2 >> 7) : (i2 >> 5);
    int h = sample ? ((i2 >> 4) & 7) : ((i2 >> 2) & 7);
    int qb = sample ? (i2 & 15) : (i2 & 3);
    if (sample) attn_item<2, 128, true>(p, seq, h, qb, lam, smem);
    else attn_item<2, 128, false>(p, seq, h, qb, lam, smem);
    if (step == (1 << 30)) break;
  }
}
__device__ __forceinline__ void na_attn_phase(const Params& p, char* smem) {
  const int b = blockIdx.x, nb = gridDim.x;
  for (int it = b; it < 2560; it += nb) {
    bool sample = it < 512;
    int i2 = sample ? it : it - 512;
    int seq = sample ? (i2 >> 8) : (i2 >> 6);
    int h = sample ? ((i2 >> 4) & 15) : ((i2 >> 2) & 15);
    int qb = sample ? (i2 & 15) : (i2 & 3);
    if (sample) attn_item<1, 64, true>(p, seq, h, qb, 0.f, smem);
    else attn_item<1, 64, false>(p, seq, h, qb, 0.f, smem);
  }
}

#define OFF_BAR (512l * 1024)
#define XB_TMO      128
#define XB_XCNT(j)  (256  + 64 * (j))
#define XB_XSUB(j)  (1280 + 64 * (j))
#define XB_XGEN(j)  (2304 + 64 * (j))
#define XB_TOP      3328
#define XB_TOPGEN   3392
#define XB_RANK(j)  (3456 + 64 * (j))
#define XCD_BAR_WORDS 4480
#define XB_SPIN_CAP (1u << 20)
#define LAS __attribute__((address_space(3)))
__device__ __forceinline__ unsigned xb_ld(unsigned* p)              { return __hip_atomic_load(p, __ATOMIC_RELAXED, __HIP_MEMORY_SCOPE_AGENT); }
__device__ __forceinline__ unsigned xb_add(unsigned* p, unsigned v) { return __hip_atomic_fetch_add(p, v, __ATOMIC_RELAXED, __HIP_MEMORY_SCOPE_AGENT); }
__device__ __forceinline__ unsigned xb_xcc_id() { return (unsigned)__builtin_amdgcn_s_getreg((3 << 11) | 20) & 0xFu; }
#define XB_SPIN(cond, bar) do { unsigned _sp = 0; while (cond) { __builtin_amdgcn_s_sleep(1); \
    if ((++_sp & 255u) == 0u) { if (xb_ld(&(bar)[XB_TMO])) break; if (_sp > XB_SPIN_CAP) { atomicAdd(&(bar)[XB_TMO], 1u); break; } } } } while (0)
struct XcdBarrier { unsigned* bar; unsigned x; volatile LAS unsigned* st; };
__device__ __forceinline__ XcdBarrier xcd_barrier_post(unsigned* bar, volatile LAS unsigned* st) {
  XcdBarrier b; b.bar = bar; b.x = xb_xcc_id(); b.st = st;
  if (threadIdx.x == 0) (void)xb_add(&bar[XB_XCNT(b.x)], 1u);
  return b;
}
__device__ __forceinline__ void xcd_barrier_complete(unsigned* bar, unsigned x, unsigned& nloc, unsigned& nx) {
  const unsigned G = gridDim.x * gridDim.y * gridDim.z;
  unsigned sum, cnt, mine, sp = 0u;
  for (;;) {
    sum = 0u; cnt = 0u; mine = 0u;
#pragma unroll
    for (unsigned j = 0; j < 16; ++j) { const unsigned c = xb_ld(&bar[XB_XCNT(j)]); sum += c; cnt += (c > 0u) ? 1u : 0u; mine = (j == x) ? c : mine; }
    if (sum == G) break;
    __builtin_amdgcn_s_sleep(1);
    if ((++sp & 255u) == 0u) { if (xb_ld(&bar[XB_TMO])) break; if (sp > XB_SPIN_CAP) { atomicAdd(&bar[XB_TMO], 1u); break; } }
  }
  nloc = mine > 0u ? mine : 1u; nx = cnt > 0u ? cnt : 1u;
}
__device__ __forceinline__ void xcd_barrier(const XcdBarrier& b) {
  asm volatile("s_waitcnt vmcnt(0)" ::: "memory");
  __syncthreads();
  if (threadIdx.x == 0) {
    unsigned* bar = b.bar;
    __builtin_amdgcn_s_waitcnt(0);
    unsigned nloc = b.st[0], nx = b.st[1];
    if (nloc == 0u) { xcd_barrier_complete(bar, b.x, nloc, nx); b.st[0] = nloc; b.st[1] = nx; }
    const unsigned old = xb_add(&bar[XB_XSUB(b.x)], 1u);
    const unsigned gen = old / nloc;
    if (old + 1u == (gen + 1u) * nloc) {
      __builtin_amdgcn_fence(__ATOMIC_RELEASE, "agent");
      asm volatile("s_waitcnt vmcnt(0)" ::: "memory");
      const unsigned og = xb_add(&bar[XB_TOP], 1u);
      const unsigned tg = og / nx;
      if (og + 1u == (tg + 1u) * nx) xb_add(&bar[XB_TOPGEN], 1u);
      else XB_SPIN(xb_ld(&bar[XB_TOPGEN]) == tg, bar);
      __builtin_amdgcn_fence(__ATOMIC_ACQUIRE, "agent");
      xb_add(&bar[XB_XGEN(b.x)], 1u);
      asm volatile("s_waitcnt vmcnt(0)" ::: "memory");
    } else {
      XB_SPIN(xb_ld(&bar[XB_XGEN(b.x)]) == gen, bar);
      __builtin_amdgcn_fence(__ATOMIC_ACQUIRE, "agent");
      asm volatile("s_waitcnt vmcnt(0)" ::: "memory");
    }
  }
  __syncthreads();
}

#define N_PHASES 27
#define N_PHASES 22
#define GSYNC(k) { xcd_barrier(xb); }
#define PH(k, body)                                   \
  if (ph_lo <= (k) && (k) < ph_hi) { body; }          \
  if (ph_lo <= (k) && (k) + 1 < ph_hi) GSYNC(k)
__global__ void __launch_bounds__(256, 2) mega(Params p, int ph_lo, int ph_hi) {
  __shared__ __attribute__((aligned(16))) char smem[73728];
  __shared__ uint4 xb_words;
  cg::grid_group grid = cg::this_grid();
  unsigned* bar = (unsigned*)(p.ws + OFF_BAR);
  if (threadIdx.x == 0) xb_words = make_uint4(0u, 0u, 0u, 0u);
  __syncthreads();
  if (ph_lo < 0) grid.sync();
  XcdBarrier xb = xcd_barrier_post(bar, (volatile LAS unsigned*)&xb_words);
  int vb = blockIdx.x;
  PH(0, prep_phase(p, smem))
  PH(1, norm_phase(p, 0))
  PH(2, gemm_phase(p, 0, smem, vb); if (gridDim.x == 512) { transposes_subset(p, smem, 0xFF0Eu, blockIdx.x, 512); mod_gemv_items(p, smem, 192, 384, blockIdx.x, 512); })
  PH(3, gemm_phase(p, 1, smem, vb))
  PH(4, gemm_phase(p, 2, smem, vb))
  PH(5, ret_ln_phase(p))
  PH(6, gemm_phase(p, 3, smem, vb))
  PH(7, norm_phase(p, 1))
  PH(8, gemm_phase(p, 4, smem, vb))
  PH(9, gemm_phase(p, 5, smem, vb))
  PH(10, rwkv_scan_phase(p, smem))
  PH(11, rwkv_post_phase(p))
  PH(12, gemm_phase(p, 6, smem, vb))
  PH(13, norm_phase(p, 2); diff_cache_prep(p))
  PH(14, gemm_phase(p, 7, smem, vb))
  PH(15, diff_attn_phase(p, smem))
  PH(16, gemm_phase(p, 10, smem, vb))
  PH(17, norm_phase(p, 3); na_cache_prep(p))
  PH(18, gemm_phase(p, 11, smem, vb))
  PH(19, na_attn_phase(p, smem))
  PH(20, gemm_phase(p, 14, smem, vb))
  PH(21, final_norm_phase(p))
}

extern "C" void kernel_launch(void* const* d_in, const int* in_sizes, int n_in,
                              void* d_out, int out_size, void* d_ws, size_t ws_size,
                              hipStream_t stream) {
  static int grid_blocks = 0;
  if (!grid_blocks) {
    int dev = 0, cus = 0, per_cu = 0;
    (void)hipGetDevice(&dev);
    (void)hipDeviceGetAttribute(&cus, hipDeviceAttributeMultiprocessorCount, dev);
    (void)hipOccupancyMaxActiveBlocksPerMultiprocessor(&per_cu, mega, 256, 0);
    if (per_cu > 2) per_cu = 2;
    if (per_cu < 1) per_cu = 1;
    grid_blocks = cus * per_cu;
  }
  Params p{};
  for (int i = 0; i < 38; ++i) p.in[i] = (const float*)d_in[i];
  p.out = (float*)d_out;
  p.ws = (char*)d_ws;
  int lo = 0, hi = N_PHASES;
  (void)hipMemsetAsync((char*)d_ws + OFF_BAR, 0, XCD_BAR_WORDS * 4, stream);
  void* args[] = {&p, &lo, &hi};
  hipError_t e = hipLaunchCooperativeKernel((void*)mega, dim3(grid_blocks), dim3(256), args, 0, stream);
  if (e != hipSuccess) fprintf(stderr, "cooperative launch failed: %s (grid %d)\n", hipGetErrorString(e), grid_blocks);
}
```
